# Optimizing an MI355X kernel written in HIP

```python
import jax, jax.numpy as jnp
from jax import lax
import numpy as np

D_MODEL = 2048
BATCH = 4
SEQ = 4096
DEPTH = 1

MIX_WIDTH = D_MODEL
MLA_WIDTH = D_MODEL // 2
HGRN_WIDTH = MIX_WIDTH - MLA_WIDTH
MLA_HEADS = 8
MLA_V_DIM = MLA_WIDTH // MLA_HEADS
MLA_NOPE_DIM = 128
MLA_ROPE_DIM = 64
MLA_Q_RANK = D_MODEL // 4
MLA_KV_RANK = D_MODEL // 8
ROPE_BASE = 10000.0
Q_BLOCK = 128
HGRN_HEADS = 8
HGRN_KEY_DIM = 128
HGRN_VAL_DIM = HGRN_WIDTH // HGRN_HEADS
HGRN_QK_WIDTH = HGRN_HEADS * HGRN_KEY_DIM
HGRN_CHUNK = 64
D_FF = 4 * D_MODEL
NORM_EPS = 1e-6
N_MOD = 6
IN_WIDTH = MLA_Q_RANK + MLA_KV_RANK + MLA_ROPE_DIM + 3 * HGRN_QK_WIDTH + 2 * HGRN_WIDTH

kernel_name = "hymba_mla_hgrn2_adaln_encoder_layer"


def _in_proj_offsets():
    widths = (MLA_Q_RANK, MLA_KV_RANK, MLA_ROPE_DIM, HGRN_QK_WIDTH, HGRN_QK_WIDTH,
              HGRN_QK_WIDTH, HGRN_WIDTH, HGRN_WIDTH)
    return [int(o) for o in np.cumsum(widths)[:-1]]


def _rmsnorm(x, g):
    xf = x.astype(jnp.float32)
    y = xf * lax.rsqrt(jnp.mean(xf * xf, axis=-1, keepdims=True) + NORM_EPS)
    return (y * g.astype(jnp.float32)).astype(x.dtype)


def _rope_angles(positions):
    half = MLA_ROPE_DIM // 2
    inv_freq = ROPE_BASE ** (-jnp.arange(half, dtype=jnp.float32) / half)
    ang = positions.astype(jnp.float32)[..., None] * inv_freq
    return jnp.cos(ang), jnp.sin(ang)


def _apply_rope(x, cos, sin):
    x1, x2 = jnp.split(x.astype(jnp.float32), 2, axis=-1)
    return jnp.concatenate([x1 * cos - x2 * sin, x1 * sin + x2 * cos], axis=-1).astype(x.dtype)


def _mla(q_lat, kv_lat, k_rope, cos, sin, q_norm_g, kv_norm_g, w_uq, w_ukv):
    B, S, _ = q_lat.shape
    H = MLA_HEADS
    q = (_rmsnorm(q_lat, q_norm_g) @ w_uq).reshape(B, S, H, MLA_NOPE_DIM + MLA_ROPE_DIM)
    q_nope = q[..., :MLA_NOPE_DIM]
    q_rope = _apply_rope(q[..., MLA_NOPE_DIM:], cos[:, :, None, :], sin[:, :, None, :])
    kv = (_rmsnorm(kv_lat, kv_norm_g) @ w_ukv).reshape(B, S, H, MLA_NOPE_DIM + MLA_V_DIM)
    k_nope, v = kv[..., :MLA_NOPE_DIM], kv[..., MLA_NOPE_DIM:]
    k_rope = _apply_rope(k_rope, cos, sin)
    scale = (MLA_NOPE_DIM + MLA_ROPE_DIM) ** -0.5
    nb = S // Q_BLOCK

    def to_blocks(t):
        return t.reshape(B, nb, Q_BLOCK, *t.shape[2:]).swapaxes(0, 1)

    def attend(blk):
        qn, qr = blk
        s = (jnp.einsum('bqhd,bkhd->bhqk', qn, k_nope)
             + jnp.einsum('bqhr,bkr->bhqk', qr, k_rope))
        p = jax.nn.softmax(s.astype(jnp.float32) * scale, axis=-1).astype(v.dtype)
        return jnp.einsum('bhqk,bkhd->bqhd', p, v)

    o = lax.map(attend, (to_blocks(q_nope), to_blocks(q_rope)))
    return o.swapaxes(0, 1).reshape(B, S, H * MLA_V_DIM)


def _gla_chunkwise(q, k, v, log_f):
    B, S, H, Dk = q.shape
    Dv = v.shape[-1]
    n = S // HGRN_CHUNK

    def to_chunks(t):
        return t.reshape(B, n, HGRN_CHUNK, H, t.shape[-1]).transpose(1, 0, 3, 2, 4)

    qc, kc, vc = to_chunks(q), to_chunks(k), to_chunks(v)
    bc = jnp.cumsum(to_chunks(log_f), axis=3)
    mask = jnp.tril(jnp.ones((HGRN_CHUNK, HGRN_CHUNK), dtype=bool))[None, None, :, :, None]

    def step(state, inp):
        q_, k_, v_, b_ = inp
        rel = jnp.where(mask, b_[:, :, :, None, :] - b_[:, :, None, :, :], -jnp.inf)
        a = jnp.einsum('bhtd,bhsd,bhtsd->bhts', q_, k_, jnp.exp(rel))
        o = (jnp.einsum('bhts,bhse->bhte', a, v_)
             + jnp.einsum('bhtd,bhde->bhte', q_ * jnp.exp(b_), state))
        b_last = b_[:, :, -1:, :]
        state = (state * jnp.exp(b_last)[:, :, 0, :, None]
                 + jnp.einsum('bhsd,bhse->bhde', k_ * jnp.exp(b_last - b_), v_))
        return state, o

    state0 = jnp.zeros((B, H, Dk, Dv), jnp.float32)
    _, o = lax.scan(step, state0, (qc, kc, vc, bc))
    return o.transpose(1, 0, 3, 2, 4).reshape(B, S, H, Dv)


def _hgrn2_direction(q, f_logit, v, lb):
    f = lb + (1.0 - lb) * jax.nn.sigmoid(f_logit.astype(jnp.float32))
    return _gla_chunkwise(q.astype(jnp.float32), 1.0 - f, v.astype(jnp.float32), jnp.log(f))


def _lower_bound(lb_logits, layer):
    p = jax.nn.softmax(lb_logits.astype(jnp.float32), axis=0)
    return jnp.cumsum(p, axis=0)[layer].reshape(HGRN_HEADS, HGRN_KEY_DIM)


def _hgrn2_bidir(hq, f_fwd, f_bwd, hi, hg, lb_fwd, lb_bwd, norm_g):
    B, S, _ = hq.shape
    q = hq.reshape(B, S, HGRN_HEADS, HGRN_KEY_DIM)
    ff = f_fwd.reshape(B, S, HGRN_HEADS, HGRN_KEY_DIM)
    fb = f_bwd.reshape(B, S, HGRN_HEADS, HGRN_KEY_DIM)
    v = hi.reshape(B, S, HGRN_HEADS, HGRN_VAL_DIM)
    o_fwd = _hgrn2_direction(q, ff, v, lb_fwd)
    o_bwd = jnp.flip(_hgrn2_direction(jnp.flip(q, 1), jnp.flip(fb, 1), jnp.flip(v, 1), lb_bwd), 1)
    o = _rmsnorm(o_fwd + o_bwd, norm_g).reshape(B, S, HGRN_WIDTH)
    return (o * jax.nn.silu(hg.astype(jnp.float32))).astype(hq.dtype)


def setup_inputs(seed: int = 0) -> dict:
    key = jax.random.key(seed)
    ks = jax.random.split(key, 24)
    f32 = jnp.float32

    def nrm(k, shape, fan_in, s=1.0):
        return jax.random.normal(k, shape, f32) * (s * fan_in ** -0.5)

    def gain(k, shape):
        return 1.0 + 0.05 * jax.random.normal(k, shape, f32)

    offs = jax.random.randint(ks[2], (BATCH, 1), 0, 1024, dtype=jnp.int32)
    positions = (jnp.arange(SEQ, dtype=jnp.int32)[None, :] + offs).astype(jnp.int32)
    return {
        "x": jax.random.normal(ks[0], (BATCH, SEQ, D_MODEL), f32),
        "c": jax.random.normal(ks[1], (BATCH, D_MODEL), f32),
        "positions": positions,
        "w_mod": nrm(ks[3], (DEPTH, D_MODEL, N_MOD * D_MODEL), D_MODEL, 0.5),
        "b_mod": 0.01 * jax.random.normal(ks[4], (DEPTH, N_MOD * D_MODEL), f32),
        "pre_mix_g": gain(ks[5], (DEPTH, D_MODEL)),
        "post_mix_g": gain(ks[6], (DEPTH, D_MODEL)),
        "pre_mlp_g": gain(ks[7], (DEPTH, D_MODEL)),
        "post_mlp_g": gain(ks[8], (DEPTH, D_MODEL)),
        "w_in": nrm(ks[9], (DEPTH, D_MODEL, IN_WIDTH), D_MODEL),
        "q_norm_g": gain(ks[10], (DEPTH, MLA_Q_RANK)),
        "kv_norm_g": gain(ks[11], (DEPTH, MLA_KV_RANK)),
        "w_uq": nrm(ks[12], (DEPTH, MLA_Q_RANK, MLA_HEADS * (MLA_NOPE_DIM + MLA_ROPE_DIM)), MLA_Q_RANK),
        "w_ukv": nrm(ks[13], (DEPTH, MLA_KV_RANK, MLA_HEADS * (MLA_NOPE_DIM + MLA_V_DIM)), MLA_KV_RANK),
        "hgrn_norm_g": gain(ks[14], (DEPTH, HGRN_VAL_DIM)),
        "hgrn_lb_logits_fwd": 0.1 * jax.random.normal(ks[15], (DEPTH + 1, HGRN_QK_WIDTH), f32),
        "hgrn_lb_logits_bwd": 0.1 * jax.random.normal(ks[16], (DEPTH + 1, HGRN_QK_WIDTH), f32),
        "w_out": nrm(ks[17], (DEPTH, MIX_WIDTH, D_MODEL), MIX_WIDTH),
        "w_up": nrm(ks[18], (DEPTH, D_MODEL, D_FF), D_MODEL),
        "w_down": nrm(ks[19], (DEPTH, D_FF, D_MODEL), D_FF),
    }


def reference(x, c, positions, w_mod, b_mod, pre_mix_g, post_mix_g, pre_mlp_g, post_mlp_g,
              w_in, q_norm_g, kv_norm_g, w_uq, w_ukv, hgrn_norm_g, hgrn_lb_logits_fwd,
              hgrn_lb_logits_bwd, w_out, w_up, w_down):
    cos, sin = _rope_angles(positions)
    cond = jax.nn.silu(c)
    offsets = _in_proj_offsets()
    for layer in range(DEPTH):
        mod = (cond @ w_mod[layer] + b_mod[layer]).astype(x.dtype)
        shift_a, scale_a, gate_a, shift_m, scale_m, gate_m = [
            m[:, None, :] for m in jnp.split(mod, N_MOD, axis=-1)]

        h = _rmsnorm(x, pre_mix_g[layer]) * (1.0 + scale_a) + shift_a
        proj = h @ w_in[layer]
        q_lat, kv_lat, k_rope, hq, f_fwd, f_bwd, hi, hg = jnp.split(proj, offsets, axis=-1)
        attn_out = _mla(q_lat, kv_lat, k_rope, cos, sin, q_norm_g[layer], kv_norm_g[layer],
                        w_uq[layer], w_ukv[layer])
        rec_out = _hgrn2_bidir(hq, f_fwd, f_bwd, hi, hg,
                               _lower_bound(hgrn_lb_logits_fwd, layer),
                               _lower_bound(hgrn_lb_logits_bwd, layer), hgrn_norm_g[layer])
        mix = jnp.concatenate([attn_out, rec_out], axis=-1) @ w_out[layer]
        x = x + gate_a * _rmsnorm(mix, post_mix_g[layer])

        h = _rmsnorm(x, pre_mlp_g[layer]) * (1.0 + scale_m) + shift_m
        y = jnp.square(jax.nn.relu(h @ w_up[layer])) @ w_down[layer]
        x = x + gate_m * _rmsnorm(y, post_mlp_g[layer])
    return x
```

```cpp
#include <hip/hip_runtime.h>
#include <hip/hip_bf16.h>
#include <cstdio>
#include <cstdint>
#include <cmath>
namespace pg8 {
#define PG8_LAS __attribute__((address_space(3)))
typedef unsigned short bf16_t;
typedef short bf16x8 __attribute__((ext_vector_type(8)));
typedef float f32x4 __attribute__((ext_vector_type(4)));
typedef unsigned u32x4 __attribute__((ext_vector_type(4)));
constexpr int BM = 256, BK = 64, HALF = 128, HTB = HALF * BK * 2  , STAGE_BYTES = 8 * HTB, NXCD = 8, WGM = 8;

__host__ __device__ __forceinline__ int lds_byte(int r, int c) { const int st = (r >> 4) * 2 + (c >> 5), rr = r & 15, cc = c & 31, ob = rr * 64 + cc * 2; return st * 1024 + (ob ^ (((ob >> 9) & 1) << 5)); }
__host__ __device__ __forceinline__ void stage_rc(int b, int& R, int& C) { const int st = b / 1024, sb = b % 1024, swz = sb ^ (((sb >> 9) & 1) << 5); R = (st >> 1) * 16 + swz / 64; C = (st & 1) * 32 + (swz % 64) / 2; }
__host__ __device__ __forceinline__ int perm32(int rho) { const int n = rho >> 4, i = rho & 15; return 8 * (i >> 2) + 4 * n + (i & 3); }

struct Unit { int pm, pn; };
struct Gemm { const bf16_t* A; const bf16_t* Bt; int M, N, K; };

struct StaticOrder {
    int nM, nN, nwg, G, c;
    __host__ __device__ void init(int M, int N, int G_, int c_) { nM = M / BM; nN = N / BM; nwg = nM * nN; G = G_; c = c_; }
    __host__ __device__ bool next(int i, Unit& u) const {
        const long L = (long)i * G + c; if (L >= nwg) return false;
        int wgid = (int)L; { const int q = nwg / NXCD, r = nwg % NXCD, xcd = wgid % NXCD, off = wgid / NXCD; wgid = (xcd < r ? xcd * (q + 1) : r * (q + 1) + (xcd - r) * q) + off; }
        const int nig = WGM * nN, gid = wgid / nig, fm = gid * WGM, gsz = (nM - fm) < WGM ? (nM - fm) : WGM;
        u.pm = fm + ((wgid % nig) % gsz); u.pn = (wgid % nig) / gsz; return true;
    }
    __device__ __forceinline__ void a_ready(const Unit&) const {}
    __device__ __forceinline__ void done(const Unit&) const {}
};

__device__ __forceinline__ unsigned cvt_pk_bf16(float lo, float hi) { unsigned r; asm volatile("v_cvt_pk_bf16_f32 %0, %1, %2" : "=v"(r) : "v"(lo), "v"(hi)); return r; }
typedef float f32x2 __attribute__((ext_vector_type(2)));
__device__ __forceinline__ u32x4 pack8(const f32x4 a, const f32x4 b) { u32x4 w; w.x = cvt_pk_bf16(a[0], a[1]); w.y = cvt_pk_bf16(a[2], a[3]); w.z = cvt_pk_bf16(b[0], b[1]); w.w = cvt_pk_bf16(b[2], b[3]); return w; }
__device__ __forceinline__ void rope8(f32x4& a, f32x4& b, const float* csp) {
    const f32x4 c0 = *(const f32x4*)csp, c1 = *(const f32x4*)(csp + 4);
    f32x4 ra, rb;
    ra[0] = a[0] * c0[0] - a[1] * c0[1]; ra[1] = a[0] * c0[1] + a[1] * c0[0];
    ra[2] = a[2] * c0[2] - a[3] * c0[3]; ra[3] = a[2] * c0[3] + a[3] * c0[2];
    rb[0] = b[0] * c1[0] - b[1] * c1[1]; rb[1] = b[0] * c1[1] + b[1] * c1[0];
    rb[2] = b[2] * c1[2] - b[3] * c1[3]; rb[3] = b[2] * c1[3] + b[3] * c1[2];
    a = ra; b = rb;
}
__device__ __forceinline__ float sq4(const f32x4 x) { return (x[0] * x[0] + x[1] * x[1]) + (x[2] * x[2] + x[3] * x[3]); }
constexpr float NORM_EPS = 1e-6f;

struct EpiProj {
    static constexpr bool PERM = true, AFTER_DRAIN = false;
    bf16_t *QL, *KVL, *HQ, *FF, *FB, *HI, *HG, *KR; float *qss, *kvss; const float* cs;
    __device__ __forceinline__ void operator()(const f32x4 (&acc)[2][2][4][2], const Unit& u, int wr, int wc, int fr, int fq) const {
        const int pn = u.pn, row0 = u.pm * BM + wr * 64 + fr, cl = wc * 32 + 8 * fq;
        if (pn == 23) {
            if (wc < 2) {
#pragma unroll
                for (int ai = 0; ai < 2; ++ai)
#pragma unroll
                    for (int m = 0; m < 4; ++m) { const int row = row0 + ai * HALF + m * 16; f32x4 a = acc[ai][0][m][0], b = acc[ai][0][m][1];
                        rope8(a, b, cs + (size_t)row * 64 + cl); *(u32x4*)(KR + (size_t)row * 64 + cl) = pack8(a, b); }
            }
            return;
        }
        bf16_t* base; int ldc, col;
        if (pn < 2) { base = QL; ldc = 512; col = pn * 256; }
        else if (pn == 2) { base = KVL; ldc = 256; col = 0; }
        else { const int s = (pn - 3) >> 2; base = s == 0 ? HQ : s == 1 ? FF : s == 2 ? FB : s == 3 ? HI : HG; ldc = 1024; col = ((pn - 3) & 3) * 256; }
#pragma unroll
        for (int ai = 0; ai < 2; ++ai)
#pragma unroll
            for (int m = 0; m < 4; ++m) { bf16_t* rowp = base + (size_t)(row0 + ai * HALF + m * 16) * ldc + col + cl;
#pragma unroll
                for (int bj = 0; bj < 2; ++bj) *(u32x4*)(rowp + bj * HALF) = pack8(acc[ai][bj][m][0], acc[ai][bj][m][1]); }
        if (pn <= 2) {
#pragma unroll
            for (int ai = 0; ai < 2; ++ai)
#pragma unroll
                for (int m = 0; m < 4; ++m) { float s = (sq4(acc[ai][0][m][0]) + sq4(acc[ai][0][m][1])) + (sq4(acc[ai][1][m][0]) + sq4(acc[ai][1][m][1]));
                    s += __shfl_xor(s, 16); s += __shfl_xor(s, 32);
                    const int row = row0 + ai * HALF + m * 16;
                    if (fq == 0) { if (pn < 2) qss[(size_t)row * 8 + pn * 4 + wc] = s; else kvss[(size_t)row * 4 + wc] = s; } }
        }
    }
};
struct EpiQ {
    static constexpr bool PERM = true, AFTER_DRAIN = false;
    bf16_t *QN, *QR; const float* qss; const float* cs;
    __device__ __forceinline__ void operator()(const f32x4 (&acc)[2][2][4][2], const Unit& u, int wr, int wc, int fr, int fq) const {
        const int pn = u.pn, row0 = u.pm * BM + wr * 64 + fr, cl = wc * 32 + 8 * fq;
#pragma unroll
        for (int ai = 0; ai < 2; ++ai)
#pragma unroll
            for (int m = 0; m < 4; ++m) { const int row = row0 + ai * HALF + m * 16;
                const f32x4 s0 = *(const f32x4*)(qss + (size_t)row * 8), s1 = *(const f32x4*)(qss + (size_t)row * 8 + 4);
                const float rstd = 1.0f / sqrtf((((s0[0] + s0[1]) + (s0[2] + s0[3])) + ((s1[0] + s1[1]) + (s1[2] + s1[3]))) * (1.0f / 512.0f) + NORM_EPS);
                if (pn < 4) {
#pragma unroll
                    for (int bj = 0; bj < 2; ++bj) *(u32x4*)(QN + (size_t)row * 1024 + pn * 256 + bj * HALF + cl) = pack8(acc[ai][bj][m][0] * rstd, acc[ai][bj][m][1] * rstd);
                } else {
#pragma unroll
                    for (int bj = 0; bj < 2; ++bj) { f32x4 a = acc[ai][bj][m][0] * rstd, b = acc[ai][bj][m][1] * rstd;
                        rope8(a, b, cs + (size_t)row * 64 + (cl & 63)); *(u32x4*)(QR + (size_t)row * 512 + (pn - 4) * 256 + bj * HALF + cl) = pack8(a, b); }
                } }
    }
};
struct EpiKV {
    static constexpr bool PERM = true, AFTER_DRAIN = false;
    bf16_t *KN, *V; const float* kvss;
    __device__ __forceinline__ void operator()(const f32x4 (&acc)[2][2][4][2], const Unit& u, int wr, int wc, int fr, int fq) const {
        const int pn = u.pn, row0 = u.pm * BM + wr * 64 + fr, cl = wc * 32 + 8 * fq;
#pragma unroll
        for (int ai = 0; ai < 2; ++ai)
#pragma unroll
            for (int m = 0; m < 4; ++m) { const int row = row0 + ai * HALF + m * 16;
                const f32x4 s0 = *(const f32x4*)(kvss + (size_t)row * 4);
                const float rstd = 1.0f / sqrtf(((s0[0] + s0[1]) + (s0[2] + s0[3])) * (1.0f / 256.0f) + NORM_EPS);
                *(u32x4*)(KN + (size_t)row * 1024 + pn * HALF + cl) = pack8(acc[ai][0][m][0] * rstd, acc[ai][0][m][1] * rstd);
                *(u32x4*)(V + (size_t)row * 1024 + pn * HALF + cl) = pack8(acc[ai][1][m][0] * rstd, acc[ai][1][m][1] * rstd); }
    }
};
template <int ACT  , bool SS> struct EpiOut {
    static constexpr bool PERM = true, AFTER_DRAIN = false;
    bf16_t* O; int ldc; float* ss;
    __device__ __forceinline__ void operator()(const f32x4 (&acc)[2][2][4][2], const Unit& u, int wr, int wc, int fr, int fq) const {
        const int pn = u.pn, row0 = u.pm * BM + wr * 64 + fr, cl = wc * 32 + 8 * fq;
#pragma unroll
        for (int ai = 0; ai < 2; ++ai)
#pragma unroll
            for (int m = 0; m < 4; ++m) { const int row = row0 + ai * HALF + m * 16; bf16_t* rowp = O + (size_t)row * ldc + pn * BM + cl;
#pragma unroll
                for (int bj = 0; bj < 2; ++bj) { f32x4 a = acc[ai][bj][m][0], b = acc[ai][bj][m][1];
                    if (ACT == 1) { a = __builtin_elementwise_max(a, (f32x4){0.f, 0.f, 0.f, 0.f}); b = __builtin_elementwise_max(b, (f32x4){0.f, 0.f, 0.f, 0.f}); a = a * a; b = b * b; }
                    *(u32x4*)(rowp + bj * HALF) = pack8(a, b); }
                if (SS) { float s = (sq4(acc[ai][0][m][0]) + sq4(acc[ai][0][m][1])) + (sq4(acc[ai][1][m][0]) + sq4(acc[ai][1][m][1]));
                    s += __shfl_xor(s, 16); s += __shfl_xor(s, 32);
                    if (fq == 0) ss[(size_t)row * 32 + pn * 4 + wc] = s; } }
    }
};
template <class Epi, class Sched, bool ALIGN_EPI = false, bool SP2 = false>
__device__ __forceinline__ void gemm_phase(PG8_LAS unsigned char* lds, const Gemm g, const Sched& S, const Epi& E) {
    const int tid = threadIdx.x, wid = __builtin_amdgcn_readfirstlane(tid >> 6), lane = tid & 63, wr = wid >> 2, wc = wid & 3, fr = lane & 15, fq = lane >> 4;
    const int K = g.K, nt = K / BK;
    unsigned voffA[2], voffB[2];
#pragma unroll
    for (int i = 0; i < 2; ++i) { int R, C; stage_rc(tid * 16 + i * 8192, R, C); const int Rb = Epi::PERM ? ((R & ~31) + perm32(R & 31)) : R;
        voffA[i] = (unsigned)(R * K + C) * 2u; voffB[i] = (unsigned)(Rb * K + C) * 2u; }
    const size_t kstep = (size_t)(BK * 2);
    const size_t hstep = (size_t)HALF * K * 2;
    const size_t tstep = 2 * hstep;
    const unsigned ldsw = (unsigned)wid * 1024u;
    const int aoff = lds_byte(wr * 64 + fr, fq * 8), boff = lds_byte(wc * 32 + fr, fq * 8);
#define PG8_SA(b, h) (((b) * 2 + (h)) * HTB)
#define PG8_SB(b, h) ((4 + (b) * 2 + (h)) * HTB)
#define PG8_STAGE(bufoff, gbase, voff) do { _Pragma("unroll") for (int _i = 0; _i < 2; ++_i) \
        __builtin_amdgcn_global_load_lds((const unsigned*)((const char*)(gbase) + (voff)[_i]), (PG8_LAS unsigned*)(lds + (bufoff) + ldsw + _i * 8192), 16, 0, 0); } while (0)
#define PG8_LDA(dst, b, h) do { _Pragma("unroll") for (int m = 0; m < 4; ++m) _Pragma("unroll") for (int k = 0; k < 2; ++k) dst[m][k] = *(const PG8_LAS bf16x8*)(lds + PG8_SA(b, h) + aoff + m * 2048 + k * 1024); } while (0)
#define PG8_LDB(dst, b, h) do { _Pragma("unroll") for (int n = 0; n < 2; ++n) _Pragma("unroll") for (int k = 0; k < 2; ++k) dst[n][k] = *(const PG8_LAS bf16x8*)(lds + PG8_SB(b, h) + boff + n * 2048 + k * 1024); } while (0)
#define PG8_MMA(ai, bj, At, Bt) do { __builtin_amdgcn_s_setprio(1); _Pragma("unroll") for (int m = 0; m < 4; ++m) _Pragma("unroll") for (int n = 0; n < 2; ++n) _Pragma("unroll") for (int k = 0; k < 2; ++k) \
        acc[ai][bj][m][n] = __builtin_amdgcn_mfma_f32_16x16x32_bf16(Bt[n][k], At[m][k], acc[ai][bj][m][n], 0, 0, 0); __builtin_amdgcn_s_setprio(0); } while (0)
#define PG8_WAIT_V(n) asm volatile("s_waitcnt vmcnt(" #n ")" ::: "memory")
#define PG8_WAIT_L(n) asm volatile("s_waitcnt lgkmcnt(" #n ")" ::: "memory")
#define PG8_BAR __builtin_amdgcn_s_barrier()
#define PG8_SCHED __builtin_amdgcn_sched_barrier(0)
    Unit cur, nxt; int ui = 0;
    if (!S.next(0, cur)) return;
    f32x4 acc[2][2][4][2];
#pragma unroll
    for (int a = 0; a < 2; ++a)
#pragma unroll
        for (int b = 0; b < 2; ++b)
#pragma unroll
            for (int m = 0; m < 4; ++m)
#pragma unroll
                for (int n = 0; n < 2; ++n) acc[a][b][m][n] = (f32x4){0.f, 0.f, 0.f, 0.f};
    bf16x8 At[4][2], B0[2][2], B1[2][2];
    const char* cA = (const char*)g.A + (size_t)cur.pm * tstep; const char* cB = (const char*)g.Bt + (size_t)cur.pn * tstep;
    S.a_ready(cur);
    if constexpr (SP2) {
        PG8_STAGE(PG8_SB(0, 0), cB, voffB); PG8_STAGE(PG8_SB(0, 1), cB + hstep, voffB); PG8_STAGE(PG8_SA(0, 0), cA, voffA); PG8_STAGE(PG8_SA(0, 1), cA + hstep, voffA);
        if (wr == 1) PG8_BAR;
        PG8_WAIT_V(2); PG8_BAR;
        PG8_STAGE(PG8_SB(1, 0), cB + kstep, voffB); PG8_STAGE(PG8_SA(1, 0), cA + kstep, voffA); PG8_STAGE(PG8_SB(1, 1), cB + hstep + kstep, voffB);
        PG8_WAIT_V(6); PG8_BAR;
    } else {
        PG8_STAGE(PG8_SB(0, 0), cB, voffB); PG8_STAGE(PG8_SA(0, 0), cA, voffA); PG8_STAGE(PG8_SB(0, 1), cB + hstep, voffB); PG8_STAGE(PG8_SA(0, 1), cA + hstep, voffA);
        if (wr == 1) PG8_BAR;
        PG8_WAIT_V(4); PG8_BAR;
        PG8_STAGE(PG8_SB(1, 0), cB + kstep, voffB); PG8_STAGE(PG8_SA(1, 0), cA + kstep, voffA); PG8_STAGE(PG8_SB(1, 1), cB + hstep + kstep, voffB);
        PG8_WAIT_V(6); PG8_BAR;
    }
    for (;;) {
        const bool has_next = S.next(ui + 1, nxt);
        const char* nA = has_next ? (const char*)g.A + (size_t)nxt.pm * tstep : cA; const char* nB = has_next ? (const char*)g.Bt + (size_t)nxt.pn * tstep : cB;
        for (int t = 0; t < nt; t += 2) {
            const bool last = (t == nt - 2);
            const char* a1 = cA + (size_t)(t + 1) * kstep;
            const char* a2 = last ? nA : cA + (size_t)(t + 2) * kstep; const char* b2 = last ? nB : cB + (size_t)(t + 2) * kstep;
            const char* a3 = a2 + kstep; const char* b3 = b2 + kstep;
            if (last && has_next) S.a_ready(nxt);
            if constexpr (SP2) {
            PG8_LDB(B0, 0, 0); PG8_LDB(B1, 0, 1); PG8_SCHED; PG8_LDA(At, 0, 0); PG8_STAGE(PG8_SA(1, 1), a1 + hstep, voffA);
            PG8_WAIT_V(8); PG8_WAIT_L(0); PG8_BAR; PG8_MMA(0, 0, At, B0); PG8_MMA(0, 1, At, B1); PG8_BAR; PG8_SCHED;
            PG8_LDA(At, 0, 1); PG8_STAGE(PG8_SB(0, 0), b2, voffB); PG8_STAGE(PG8_SB(0, 1), b2 + hstep, voffB); PG8_STAGE(PG8_SA(0, 0), a2, voffA);
            PG8_WAIT_V(8); PG8_WAIT_L(0); PG8_BAR; PG8_MMA(1, 0, At, B0); PG8_MMA(1, 1, At, B1); PG8_BAR; PG8_SCHED;
            PG8_LDB(B0, 1, 0); PG8_LDB(B1, 1, 1); PG8_SCHED; PG8_LDA(At, 1, 0); PG8_STAGE(PG8_SA(0, 1), a2 + hstep, voffA);
            PG8_WAIT_V(8); PG8_WAIT_L(0); PG8_BAR; PG8_MMA(0, 0, At, B0); PG8_MMA(0, 1, At, B1); PG8_BAR; PG8_SCHED;
            PG8_LDA(At, 1, 1); PG8_STAGE(PG8_SB(1, 0), b3, voffB); PG8_STAGE(PG8_SB(1, 1), b3 + hstep, voffB); PG8_STAGE(PG8_SA(1, 0), a3, voffA);
            PG8_WAIT_V(8); PG8_WAIT_L(0); PG8_BAR; PG8_MMA(1, 0, At, B0); PG8_MMA(1, 1, At, B1); PG8_BAR; PG8_SCHED;
            } else {
            PG8_LDB(B0, 0, 0); PG8_SCHED; PG8_LDA(At, 0, 0); PG8_STAGE(PG8_SA(1, 1), a1 + hstep, voffA);
            PG8_WAIT_L(8); PG8_BAR; PG8_WAIT_L(0); PG8_MMA(0, 0, At, B0); PG8_BAR; PG8_SCHED;
            PG8_LDB(B1, 0, 1); PG8_STAGE(PG8_SB(0, 0), b2, voffB);
            PG8_BAR; PG8_WAIT_L(0); PG8_MMA(0, 1, At, B1); PG8_BAR;
            PG8_LDA(At, 0, 1); PG8_STAGE(PG8_SA(0, 0), a2, voffA);
            PG8_BAR; PG8_WAIT_L(0); PG8_MMA(1, 0, At, B0); PG8_BAR; PG8_SCHED;
            PG8_STAGE(PG8_SB(0, 1), b2 + hstep, voffB);
            PG8_WAIT_V(6); PG8_BAR; PG8_MMA(1, 1, At, B1); PG8_BAR;
            PG8_LDB(B0, 1, 0); PG8_SCHED; PG8_LDA(At, 1, 0); PG8_STAGE(PG8_SA(0, 1), a2 + hstep, voffA);
            PG8_WAIT_L(8); PG8_BAR; PG8_WAIT_L(0); PG8_MMA(0, 0, At, B0); PG8_BAR; PG8_SCHED;
            PG8_LDB(B1, 1, 1); PG8_STAGE(PG8_SB(1, 0), b3, voffB);
            PG8_BAR; PG8_WAIT_L(0); PG8_MMA(0, 1, At, B1); PG8_BAR;
            PG8_LDA(At, 1, 1); PG8_STAGE(PG8_SA(1, 0), a3, voffA);
            PG8_BAR; PG8_WAIT_L(0); PG8_MMA(1, 0, At, B0); PG8_BAR; PG8_SCHED;
            PG8_STAGE(PG8_SB(1, 1), b3 + hstep, voffB);
            PG8_WAIT_V(6); PG8_BAR; PG8_MMA(1, 1, At, B1); PG8_BAR;
            }
        }
        if constexpr (ALIGN_EPI) { if (wr == 0) PG8_BAR; }
        if constexpr (!Epi::AFTER_DRAIN) { E(acc, cur, wr, wc, fr, fq); S.done(cur); }
        if (!has_next) break;
#pragma unroll
        for (int a = 0; a < 2; ++a)
#pragma unroll
            for (int b = 0; b < 2; ++b)
#pragma unroll
                for (int m = 0; m < 4; ++m)
#pragma unroll
                    for (int n = 0; n < 2; ++n) acc[a][b][m][n] = (f32x4){0.f, 0.f, 0.f, 0.f};
        cur = nxt; cA = nA; cB = nB; ++ui;
        if constexpr (ALIGN_EPI) { if (wr == 1) PG8_BAR; }
    }
    PG8_WAIT_V(0);
    if constexpr (!ALIGN_EPI) { if (wr == 0) PG8_BAR; }
    PG8_BAR;
    if constexpr (Epi::AFTER_DRAIN) { E.fused(acc, cur, wr, wc, fr, fq, lds, wid, lane); S.done(cur); }
#undef PG8_SA
#undef PG8_SB
#undef PG8_STAGE
#undef PG8_LDA
#undef PG8_LDB
#undef PG8_MMA
#undef PG8_WAIT_V
#undef PG8_WAIT_L
#undef PG8_BAR
#undef PG8_SCHED
}
}
#define PG8_SP2 true
#define PG8_ALIGN true
namespace att {
using bf16x8 = __attribute__((ext_vector_type(8))) short;
using s16x4  = __attribute__((ext_vector_type(4))) short;
using f32x16 = __attribute__((ext_vector_type(16))) float;
using u32x4  = __attribute__((ext_vector_type(4))) unsigned;
constexpr int NW = 8, QBLK = 32, KVBLK = 64, SEQ = 4096;
constexpr float SCALE = 0.07216878364870322f;
constexpr float THR = 8.f;
#ifndef ATT_SDEPTH
#define ATT_SDEPTH 1
#endif
#ifndef QKT_SB
#define QKT_SB 0
#endif
constexpr int SDEPTH = ATT_SDEPTH;
constexpr int SHM_V = 16384, SHM_KN = 64 * 272, SHM_KR = 64 * 144;
constexpr int OFF_V = 0, OFF_KN = 2 * SHM_V, OFF_KR = OFF_KN + 2 * SHM_KN, OFF_WS = OFF_KR + 2 * SHM_KR, OFF_QR = OFF_WS + NW * 64 * 4, LDS_BYTES = OFF_QR + NW * 4096;
#define KSWZ(row, colB) ((row) * 272 + (colB))
#define KRSWZ(row, colB) ((row) * 144 + (colB))
#define SBAR() __builtin_amdgcn_sched_barrier(0)
__device__ __forceinline__ int crow(int r, int hi) { return (r & 3) + 8 * (r >> 2) + 4 * hi; }
__device__ __forceinline__ unsigned cvtpk(float lo, float hi) { unsigned r; asm volatile("v_cvt_pk_bf16_f32 %0, %1, %2" : "=v"(r) : "v"(lo), "v"(hi)); return r; }
__device__ __forceinline__ void partialSM(f32x16& p0, f32x16& p1, float& m_reg, float& mn, float& alpha) {
  constexpr float C = SCALE * 1.4426950408889634f;
  float pmax = p0[0]; for (int r = 1; r < 16; ++r) pmax = fmaxf(pmax, p0[r]); for (int r = 0; r < 16; ++r) pmax = fmaxf(pmax, p1[r]);
  { auto rr = __builtin_amdgcn_permlane32_swap(__float_as_uint(pmax), __float_as_uint(pmax), false, false);
    pmax = fmaxf(__uint_as_float(rr[0]), __uint_as_float(rr[1])); }
  if (__builtin_expect(__all(pmax - m_reg <= THR / SCALE), 1)) { mn = m_reg; alpha = 1.f; }
  else { mn = fmaxf(m_reg, pmax); alpha = __builtin_amdgcn_exp2f((m_reg - mn) * C); m_reg = mn; }
  float mnC = -mn * C;
  for (int r = 0; r < 16; ++r) p0[r] = fmaf(p0[r], C, mnC); for (int r = 0; r < 16; ++r) p1[r] = fmaf(p1[r], C, mnC);
  for (int r = 0; r < 16; ++r) p0[r] = __builtin_amdgcn_exp2f(p0[r]);
}
__device__ __forceinline__ void finishSM(f32x16& p0, f32x16& p1, float alpha, float& l_reg, bf16x8& pa0, bf16x8& pa1, bf16x8& pa2, bf16x8& pa3) {
  for (int r = 0; r < 16; ++r) p1[r] = __builtin_amdgcn_exp2f(p1[r]);
  float ps = 0; for (int r = 0; r < 16; ++r) ps += p0[r]; for (int r = 0; r < 16; ++r) ps += p1[r];
  { auto rr = __builtin_amdgcn_permlane32_swap(__float_as_uint(ps), __float_as_uint(ps), false, false);
    ps = __uint_as_float(rr[0]) + __uint_as_float(rr[1]); }
  l_reg = l_reg * alpha + ps;
#define PK4(P, BASE, OUT) do { unsigned a0 = cvtpk(P[BASE + 0], P[BASE + 1]), a1 = cvtpk(P[BASE + 2], P[BASE + 3]);   \
    unsigned b0 = cvtpk(P[BASE + 4], P[BASE + 5]), b1 = cvtpk(P[BASE + 6], P[BASE + 7]);                              \
    auto r0 = __builtin_amdgcn_permlane32_swap(a0, b0, false, false); auto r1 = __builtin_amdgcn_permlane32_swap(a1, b1, false, false); \
    u32x4 w = {r0[0], r1[0], r0[1], r1[1]}; OUT = *reinterpret_cast<bf16x8*>(&w); } while (0)
  PK4(p0, 0, pa0); PK4(p0, 8, pa1); PK4(p1, 0, pa2); PK4(p1, 8, pa3);
#undef PK4
}
__device__ __forceinline__ void qkt(f32x16& p0, f32x16& p1, const char* Kn, const char* Kr, const bf16x8* qr, const char* qrl, int r32, int hi) {
  p0 = f32x16{}; p1 = f32x16{};
#pragma unroll
  for (int d0 = 0; d0 < 8; ++d0) { const int cb = (d0 * 16 + hi * 8) * 2;
    const bf16x8 b0 = *reinterpret_cast<const bf16x8*>(Kn + KSWZ(r32, cb));
    const bf16x8 b1 = *reinterpret_cast<const bf16x8*>(Kn + KSWZ(32 + r32, cb));
    p0 = __builtin_amdgcn_mfma_f32_32x32x16_bf16(b0, qr[d0], p0, 0, 0, 0);
    p1 = __builtin_amdgcn_mfma_f32_32x32x16_bf16(b1, qr[d0], p1, 0, 0, 0);
    if (QKT_SB && (d0 & 3) == 3) SBAR(); }
#pragma unroll
  for (int d0 = 0; d0 < 4; ++d0) { const int cb = (d0 * 16 + hi * 8) * 2;
    const bf16x8 b0 = *reinterpret_cast<const bf16x8*>(Kr + KRSWZ(r32, cb));
    const bf16x8 b1 = *reinterpret_cast<const bf16x8*>(Kr + KRSWZ(32 + r32, cb));
    const bf16x8 qf = *reinterpret_cast<const bf16x8*>(qrl + d0 * 1024);
    p0 = __builtin_amdgcn_mfma_f32_32x32x16_bf16(b0, qf, p0, 0, 0, 0);
    p1 = __builtin_amdgcn_mfma_f32_32x32x16_bf16(b1, qf, p1, 0, 0, 0); }
}
__device__ __forceinline__ int v_st(int k, int c) { const int kk = (k & ~0xC) | ((k & 4) << 1) | ((k & 8) >> 1); return ((kk >> 3) * 4 + (c >> 5)) * 512 + ((kk & 7) * 32 + (c & 31)) * 2; }
__device__ __forceinline__ int v_rd_base(int lane) { return ((lane & 3) << 3) | (((lane >> 2) & 3) << 6) | (((lane >> 4) & 1) << 5) | (((lane >> 5) & 1) << 8); }
constexpr int v_rd_off(int d0, int ks, int half) { return d0 * 512 + ks * 4096 + half * 2048; }
template <int OFF> __device__ __forceinline__ s16x4 tr_read(int vb) {
  s16x4 r; asm volatile("ds_read_b64_tr_b16 %0, %1 offset:%2" : "=&v"(r) : "v"(vb), "i"(OFF) : "memory"); return r;
}
template <int D0> __device__ __forceinline__ void pv_one(f32x16& od, int vb, bf16x8 pa0, bf16x8 pa1, bf16x8 pa2, bf16x8 pa3) {
  const s16x4 l0 = tr_read<v_rd_off(D0, 0, 0)>(vb), h0 = tr_read<v_rd_off(D0, 0, 1)>(vb), l1 = tr_read<v_rd_off(D0, 1, 0)>(vb), h1 = tr_read<v_rd_off(D0, 1, 1)>(vb);
  const s16x4 l2 = tr_read<v_rd_off(D0, 2, 0)>(vb), h2 = tr_read<v_rd_off(D0, 2, 1)>(vb), l3 = tr_read<v_rd_off(D0, 3, 0)>(vb), h3 = tr_read<v_rd_off(D0, 3, 1)>(vb);
  asm volatile("s_waitcnt lgkmcnt(0)" ::: "memory"); SBAR();
#define PK(L, H) (bf16x8){L[0], L[1], L[2], L[3], H[0], H[1], H[2], H[3]}
  od = __builtin_amdgcn_mfma_f32_32x32x16_bf16(pa0, PK(l0, h0), od, 0, 0, 0);
  od = __builtin_amdgcn_mfma_f32_32x32x16_bf16(pa1, PK(l1, h1), od, 0, 0, 0);
  od = __builtin_amdgcn_mfma_f32_32x32x16_bf16(pa2, PK(l2, h2), od, 0, 0, 0);
  od = __builtin_amdgcn_mfma_f32_32x32x16_bf16(pa3, PK(l3, h3), od, 0, 0, 0);
#undef PK
}
__device__ __forceinline__ void pv_d0(f32x16* o, int vb, bf16x8 pa0, bf16x8 pa1, bf16x8 pa2, bf16x8 pa3) {
  pv_one<0>(o[0], vb, pa0, pa1, pa2, pa3); pv_one<1>(o[1], vb, pa0, pa1, pa2, pa3); pv_one<2>(o[2], vb, pa0, pa1, pa2, pa3); pv_one<3>(o[3], vb, pa0, pa1, pa2, pa3);
}
struct Tens { const short* QN; const short* QR; const short* KN; const short* KR; const short* V; unsigned short* O; };
__device__ __forceinline__ unsigned short f2bf_rne(float f) { unsigned u = __builtin_bit_cast(unsigned, f); return (unsigned short)((u + 0x7fffu + ((u >> 16) & 1u)) >> 16); }
__device__ __forceinline__ void attn_unit(int b, int h, int qb, const Tens& T, char* lds) {
  int tid = threadIdx.x; asm volatile("" : "+v"(tid));
  const int wid = tid >> 6, lane = tid & 63, r32 = lane & 31, hi = lane >> 5;
  char* V_lds = lds + OFF_V; char* KN_lds = lds + OFF_KN; char* KR_lds = lds + OFF_KR;
  char* qrl = lds + OFF_QR + wid * 4096 + lane * 16; float* ws = (float*)(lds + OFF_WS) + wid * 64; float* li_l = ws; float* al_l = ws + 32;
  float m_reg = -1e30f, l_reg = 0; f32x16 o[4] = {}; bf16x8 qr[8];
  const long rowbase = (long)b * SEQ, qrow = rowbase + qb * 256 + wid * QBLK + r32;
  { const short* Qn = T.QN + qrow * 1024 + h * 128 + hi * 8; const short* Qr = T.QR + qrow * 512 + h * 64 + hi * 8;
#pragma unroll
    for (int d0 = 0; d0 < 8; ++d0) qr[d0] = *reinterpret_cast<const bf16x8*>(Qn + d0 * 16);
#pragma unroll
    for (int d0 = 0; d0 < 4; ++d0) *reinterpret_cast<bf16x8*>(qrl + d0 * 1024) = *reinterpret_cast<const bf16x8*>(Qr + d0 * 16); }
  const short* Kn = T.KN + rowbase * 1024 + h * 128; const short* Vh = T.V + rowbase * 1024 + h * 128; const short* Kr = T.KR + rowbase * 64;
  const int sr = tid >> 4, sc = (tid & 15) * 8, vst0 = v_st(sr, sc), vst1 = v_st(32 + sr, sc);
  const int krr = tid >> 3, krc = (tid & 7) * 8;
  const int vb0 = (int)(uintptr_t)V_lds + v_rd_base(lane);
  struct { bf16x8 vs0, vs1, ks0, ks1, kr; } sr_[SDEPTH];
#define LD8(p) (*reinterpret_cast<const bf16x8*>(p))
#define SLOAD(i, k0) do { sr_[i].vs0 = LD8(&Vh[(long)((k0) + sr) * 1024 + sc]); sr_[i].vs1 = LD8(&Vh[(long)((k0) + 32 + sr) * 1024 + sc]); \
    sr_[i].ks0 = LD8(&Kn[(long)((k0) + sr) * 1024 + sc]); sr_[i].ks1 = LD8(&Kn[(long)((k0) + 32 + sr) * 1024 + sc]); sr_[i].kr = LD8(&Kr[(long)((k0) + krr) * 64 + krc]); } while (0)
#define SWRITE(bb, i) do { *(bf16x8*)(V_lds + (bb) * SHM_V + vst0) = sr_[i].vs0; *(bf16x8*)(V_lds + (bb) * SHM_V + vst1) = sr_[i].vs1; const int kc = sc * 2; \
    *(bf16x8*)(KN_lds + (bb) * SHM_KN + KSWZ(sr, kc)) = sr_[i].ks0; *(bf16x8*)(KN_lds + (bb) * SHM_KN + KSWZ(32 + sr, kc)) = sr_[i].ks1; \
    *(bf16x8*)(KR_lds + (bb) * SHM_KR + KRSWZ(krr, krc * 2)) = sr_[i].kr; } while (0)
#define SWAIT() do { if constexpr (SDEPTH == 2) asm volatile("s_waitcnt vmcnt(5)" ::: "memory"); else asm volatile("s_waitcnt vmcnt(0)" ::: "memory"); } while (0)
#define RESC(a) do { if (__any((a) < 1.f)) { if (hi == 0) al_l[r32] = (a); asm volatile("s_waitcnt lgkmcnt(0)" ::: "memory"); \
    for (int d = 0; d < 4; ++d) for (int r = 0; r < 16; ++r) o[d][r] *= al_l[crow(r, hi)]; } } while (0)
  f32x16 pA0, pA1, pB0, pB1; float mnA, mnB, alA, alB; bf16x8 pa0, pa1, pa2, pa3; constexpr int NT = SEQ / KVBLK;
  constexpr int SE = 0, SO = SDEPTH - 1;
  SLOAD(SE, 0); asm volatile("s_waitcnt vmcnt(0)" ::: "memory"); SWRITE(0, SE); __syncthreads();
  qkt(pA0, pA1, KN_lds, KR_lds, qr, qrl, r32, hi); partialSM(pA0, pA1, m_reg, mnA, alA);
  SLOAD(SO, KVBLK); if constexpr (SDEPTH == 2) { if (2 < NT) SLOAD(SE, 2 * KVBLK); }
  SWAIT(); SWRITE(1, SO); __syncthreads();
  for (int j = 1; j + 1 < NT; j += 2) {
    SBAR(); qkt(pB0, pB1, KN_lds + SHM_KN, KR_lds + SHM_KR, qr, qrl, r32, hi);
    finishSM(pA0, pA1, alA, l_reg, pa0, pa1, pa2, pa3); SBAR();
    SLOAD(SO, (j + SDEPTH) * KVBLK); SBAR();
    pv_d0(o, vb0, pa0, pa1, pa2, pa3); partialSM(pB0, pB1, m_reg, mnB, alB);
    __syncthreads(); SWAIT(); SWRITE(0, SE);
    RESC(alB); __syncthreads();
    SBAR(); qkt(pA0, pA1, KN_lds, KR_lds, qr, qrl, r32, hi);
    finishSM(pB0, pB1, alB, l_reg, pa0, pa1, pa2, pa3); SBAR();
    if (SDEPTH == 1 || j + 3 < NT) SLOAD(SE, (j + 1 + SDEPTH) * KVBLK); SBAR();
    pv_d0(o, vb0 + SHM_V, pa0, pa1, pa2, pa3); partialSM(pA0, pA1, m_reg, mnA, alA);
    __syncthreads(); SWAIT(); SWRITE(1, SO);
    RESC(alA); __syncthreads();
  }
  SBAR(); qkt(pB0, pB1, KN_lds + SHM_KN, KR_lds + SHM_KR, qr, qrl, r32, hi);
  finishSM(pA0, pA1, alA, l_reg, pa0, pa1, pa2, pa3); SBAR();
  pv_d0(o, vb0, pa0, pa1, pa2, pa3); partialSM(pB0, pB1, m_reg, mnB, alB);
  __syncthreads(); RESC(alB);
  finishSM(pB0, pB1, alB, l_reg, pa0, pa1, pa2, pa3); SBAR();
  pv_d0(o, vb0 + SHM_V, pa0, pa1, pa2, pa3);
  if (hi == 0) li_l[r32] = l_reg; asm volatile("s_waitcnt lgkmcnt(0)" ::: "memory");
  float rli[16];
#pragma unroll
  for (int r = 0; r < 16; ++r) rli[r] = __builtin_amdgcn_rcpf(li_l[crow(r, hi)]);
  __syncthreads();
  { unsigned short* stg = (unsigned short*)(lds + wid * 8192);
#pragma unroll
    for (int r = 0; r < 16; ++r) { const int orow = crow(r, hi);
#pragma unroll
      for (int d0 = 0; d0 < 4; ++d0) stg[orow * 128 + d0 * 32 + r32] = f2bf_rne(o[d0][r] * rli[r]); }
    asm volatile("s_waitcnt lgkmcnt(0)" ::: "memory");
    unsigned short* Ow = T.O + (rowbase + qb * 256 + wid * QBLK) * 2048 + h * 128;
#pragma unroll
    for (int i = 0; i < 8; ++i) { const int row = i * 4 + (lane >> 4), ch = lane & 15; const u32x4 v = *(const u32x4*)(stg + row * 128 + ch * 8); *(u32x4*)(Ow + (long)row * 2048 + ch * 8) = v; } }
  __syncthreads();
#undef LD8
#undef SLOAD
#undef SWRITE
#undef SWAIT
#undef RESC
}
#undef KSWZ
#undef KRSWZ
#undef SBAR
}
constexpr int NWAVES = 8;
#ifndef MK_N_LAUNCHES
#define MK_N_LAUNCHES 1
#endif
constexpr int NPH = 11;
constexpr int N_LAUNCHES = MK_N_LAUNCHES;
static_assert(N_LAUNCHES == 1 || N_LAUNCHES == NPH, "MK_N_LAUNCHES is 1 or NPH");

constexpr int NB = 4, SEQ = 4096, DM = 2048, M = NB * SEQ, FFD = 8192, NIN = 6144  , NIN_SRC = 5952, NMOD = 6 * DM;
constexpr size_t MiB = 1u << 20;
constexpr size_t WS_CTL = 0, CTL_ZERO_BYTES = 64 * 1024;
constexpr size_t WS_WIN = 1 * MiB, WS_QR = 1 * MiB  , WS_WUQ = 25 * MiB, WS_WUKV = 27 * MiB, WS_WOUT = 28 * MiB, WS_WUP = 36 * MiB, WS_WDN = 68 * MiB;
constexpr size_t WS_MOD = 100 * MiB, WS_CS = 101 * MiB, WS_QSS = 105 * MiB, WS_KVSS = 105 * MiB + 512 * 1024, WS_RSS = 106 * MiB, WS_KR = 108 * MiB;
constexpr size_t WS_XN = 112 * MiB, WS_OF = 112 * MiB, WS_OB = 144 * MiB, WS_Y = 112 * MiB;
constexpr size_t WS_HQ = 176 * MiB, WS_FF = 208 * MiB, WS_FB = 240 * MiB, WS_HI = 272 * MiB, WS_HG = 304 * MiB, WS_QN = 336 * MiB, WS_KN = 368 * MiB, WS_V = 400 * MiB;
constexpr size_t WS_QL = 432 * MiB, WS_KVL = 448 * MiB, WS_MIXIN = 448 * MiB, WS_MIX = 176 * MiB, WS_H = 176 * MiB, WS_END = 512 * MiB;
constexpr int CW_BAR = 4096;
constexpr int RING_OFF = 0, RING_BYTES = 131072, LDSCTL_OFF = RING_BYTES, MISC_OFF = LDSCTL_OFF + 320, LDS_BYTES = 147456;
static_assert(att::LDS_BYTES <= RING_BYTES, "attention scratch inside the ring");

#define GAS __attribute__((address_space(1)))
#define LAS __attribute__((address_space(3)))
typedef unsigned short bf16;
typedef unsigned v4u __attribute__((ext_vector_type(4)));
typedef float f32x4 __attribute__((ext_vector_type(4)));
typedef short bf16x8 __attribute__((ext_vector_type(8)));
typedef GAS unsigned gu32;
typedef GAS unsigned long long gu64;
#define RLX_AGENT __ATOMIC_RELAXED, __HIP_MEMORY_SCOPE_AGENT
#define LDS_WAIT() asm volatile("s_waitcnt lgkmcnt(0)" ::: "memory")
#define VM_WAIT() asm volatile("s_waitcnt vmcnt(0)" ::: "memory")
__device__ __forceinline__ unsigned long long rt() { return __builtin_amdgcn_s_memrealtime(); }
__device__ __forceinline__ unsigned f2bf(float f) { unsigned u = __builtin_bit_cast(unsigned, f); return (u + 0x7fffu + ((u >> 16) & 1u)) >> 16; }
__device__ __forceinline__ unsigned pk2(float lo, float hi) { return f2bf(lo) | (f2bf(hi) << 16); }
#define XB_TMO      128
#define XB_XCNT(j)  (256  + 64 * (j))
#define XB_XSUB(j)  (1280 + 64 * (j))
#define XB_XGEN(j)  (2304 + 64 * (j))
#define XB_TOP      3328
#define XB_TOPGEN   3392
#define XCD_BAR_WORDS 3456
#define XB_SPIN_CAP (1u << 18)

__device__ __forceinline__ unsigned xb_ld(unsigned* p)              { return __hip_atomic_load(p, __ATOMIC_RELAXED, __HIP_MEMORY_SCOPE_AGENT); }
__device__ __forceinline__ unsigned xb_add(unsigned* p, unsigned v) { return __hip_atomic_fetch_add(p, v, __ATOMIC_RELAXED, __HIP_MEMORY_SCOPE_AGENT); }
__device__ __forceinline__ unsigned xb_xcc_id() { return (unsigned)__builtin_amdgcn_s_getreg((3 << 11) | 20) & 0xFu; }
#define XB_SPIN(cond, bar) do { unsigned _sp = 0; while (cond) { __builtin_amdgcn_s_sleep(1); \
    if ((++_sp & 255u) == 0u) { if (xb_ld(&(bar)[XB_TMO])) break; if (_sp > XB_SPIN_CAP) { atomicAdd(&(bar)[XB_TMO], 1u); break; } } } } while (0)

struct XcdBarrier {
    unsigned* bar; unsigned x;
    volatile LAS unsigned* st;
};

__device__ __forceinline__ XcdBarrier xcd_barrier_post(unsigned* bar, volatile LAS unsigned* st) {
    XcdBarrier b; b.bar = bar; b.x = xb_xcc_id(); b.st = st;
    if (threadIdx.x == 0) (void)xb_add(&bar[XB_XCNT(b.x)], 1u);
    return b;
}
__device__ __forceinline__ void xcd_barrier_complete(unsigned* bar, unsigned x, unsigned& nloc, unsigned& nx) {
    const unsigned G = gridDim.x * gridDim.y * gridDim.z;
    unsigned sum, cnt, mine, sp = 0u;
    for (;;) {
        sum = 0u; cnt = 0u; mine = 0u;
#pragma unroll
        for (unsigned j = 0; j < 16; ++j) { const unsigned c = xb_ld(&bar[XB_XCNT(j)]); sum += c; cnt += (c > 0u) ? 1u : 0u; mine = (j == x) ? c : mine; }
        if (sum == G) break;
        __builtin_amdgcn_s_sleep(1);
        if ((++sp & 255u) == 0u) { if (xb_ld(&bar[XB_TMO])) break; if (sp > XB_SPIN_CAP) { atomicAdd(&bar[XB_TMO], 1u); break; } }
    }
    nloc = mine > 0u ? mine : 1u; nx = cnt > 0u ? cnt : 1u;
}

__device__ __forceinline__ void xcd_barrier(const XcdBarrier& b) {
    asm volatile("s_waitcnt vmcnt(0)" ::: "memory");
    __syncthreads();
    if (threadIdx.x == 0) {
        unsigned* bar = b.bar;
        __builtin_amdgcn_s_waitcnt(0);
        unsigned nloc = b.st[0], nx = b.st[1];
        if (nloc == 0u) { xcd_barrier_complete(bar, b.x, nloc, nx); b.st[0] = nloc; b.st[1] = nx; }
        const unsigned old = xb_add(&bar[XB_XSUB(b.x)], 1u);
        const unsigned gen = old / nloc;
        if (old + 1u == (gen + 1u) * nloc) {
            __builtin_amdgcn_fence(__ATOMIC_RELEASE, "agent");
            asm volatile("s_waitcnt vmcnt(0)" ::: "memory");
            const unsigned og = xb_add(&bar[XB_TOP], 1u);
            const unsigned tg = og / nx;
            if (og + 1u == (tg + 1u) * nx) xb_add(&bar[XB_TOPGEN], 1u);
            else XB_SPIN(xb_ld(&bar[XB_TOPGEN]) == tg, bar);
            __builtin_amdgcn_fence(__ATOMIC_ACQUIRE, "agent");
            xb_add(&bar[XB_XGEN(b.x)], 1u);
            asm volatile("s_waitcnt vmcnt(0)" ::: "memory");
        } else {
            XB_SPIN(xb_ld(&bar[XB_XGEN(b.x)]) == gen, bar);
            __builtin_amdgcn_fence(__ATOMIC_ACQUIRE, "agent");
            asm volatile("s_waitcnt vmcnt(0)" ::: "memory");
        }
    }
    __syncthreads();
}

__device__ __forceinline__ float wave_sum(float v) {
#pragma unroll
    for (int o = 1; o < 64; o <<= 1) v += __shfl_xor(v, o);
    return v;
}
__device__ __forceinline__ float bf2f(unsigned short h) { return __builtin_bit_cast(float, (unsigned)h << 16); }
__device__ __forceinline__ float bflo(unsigned w) { return __builtin_bit_cast(float, w << 16); }
__device__ __forceinline__ float bfhi(unsigned w) { return __builtin_bit_cast(float, w & 0xffff0000u); }
__device__ __forceinline__ float sigmoidf_(float x) { return 1.0f / (1.0f + __expf(-x)); }

struct Args { const float* in[20]; float* out; unsigned char* ws; int ph_lo, ph_hi; };
struct Ctx { int tid, lane, wave, vcu, G; LAS unsigned char* lds; };

template <int MODE> __device__ __forceinline__ int src_col(int n) {
    if (MODE == 1) { if (n < 768) return n; if (n < 5888) return n + 64; if (n < 5952) { const int j = n - 5888; return 768 + (j & 1) * 32 + (j >> 1); } return -1; }
    if (MODE == 2) { if (n < 1024) return (n >> 7) * 192 + (n & 127); const int r = n - 1024, h = r >> 6, j = r & 63; return h * 192 + 128 + (j & 1) * 32 + (j >> 1); }
    return n;
}
template <int MODE> __device__ __forceinline__ void transpose_item(const float* W, int K, int Nsrc, int Ndst, const float* gain, bf16* WT, LAS float* scr, int item, int lane) {
    const int nblk = Ndst / 32, kb = item / nblk, nb = item % nblk, k0 = 64 * kb, n0 = 32 * nb;
    const int c = src_col<MODE>(n0 + (lane & 31));
#pragma unroll 8
    for (int i = 0; i < 32; ++i) { const int kk = 2 * i + (lane >> 5); float v = 0.f; if (c >= 0) v = W[(size_t)(k0 + kk) * Nsrc + c]; if (gain) v *= gain[k0 + kk]; scr[kk * 33 + (lane & 31)] = v; }
    LDS_WAIT(); asm volatile("" ::: "memory");
    const int cc = lane & 7;
#pragma unroll
    for (int j = 0; j < 4; ++j) { const int n = (lane >> 3) + 8 * j; const LAS float* s = scr + (8 * cc) * 33 + n;
        v4u o; o.x = pk2(s[0 * 33], s[1 * 33]); o.y = pk2(s[2 * 33], s[3 * 33]); o.z = pk2(s[4 * 33], s[5 * 33]); o.w = pk2(s[6 * 33], s[7 * 33]);
        *(GAS v4u*)(WT + (size_t)(n0 + n) * K + k0 + 8 * cc) = o; }
    LDS_WAIT(); asm volatile("" ::: "memory");
}

__global__ void __launch_bounds__(NWAVES * 64, 2) mk_fwd(Args args) {
    extern __shared__ __attribute__((aligned(16))) unsigned char lds[];
    Ctx C; C.lds = (LAS unsigned char*)lds; C.tid = threadIdx.x; C.lane = C.tid & 63; C.wave = __builtin_amdgcn_readfirstlane(C.tid >> 6);
    C.G = gridDim.x; { const int bx = blockIdx.x; C.vcu = (C.G % 8 == 0) ? (bx % 8) * (C.G / 8) + bx / 8 : bx; }
    volatile LAS unsigned* MISC = (volatile LAS unsigned*)(C.lds + MISC_OFF);
    unsigned char* ws = args.ws;
    gu32* ctl = (gu32*)(ws + WS_CTL);
    for (int u = C.tid; u < (LDS_BYTES - LDSCTL_OFF) / 4; u += NWAVES * 64) ((LAS unsigned*)(C.lds + LDSCTL_OFF))[u] = 0u;
    __syncthreads();
    XcdBarrier bar; bar.bar = (unsigned*)(ctl + CW_BAR); bar.x = 0; bar.st = nullptr;
    if (N_LAUNCHES == 1) bar = xcd_barrier_post((unsigned*)(ctl + CW_BAR), MISC + 8);
#define GRID_BAR() do { if (N_LAUNCHES == 1) xcd_barrier(bar); } while (0)
    const int lo = args.ph_lo, hi = args.ph_hi;
#ifndef PH_MASK
#define PH_MASK 0xfff
#endif
#define IN(k) (((PH_MASK >> (k)) & 1) && lo <= (k) && (k) < hi)
#define BOTH(k) (IN(k) && IN((k) + 1))
    const int gw = C.vcu * NWAVES + C.wave, NGW = C.G * NWAVES;
    const float* x = args.in[0]; const float* cin = args.in[1]; const int* positions = (const int*)args.in[2];
    const float* w_mod = args.in[3]; const float* b_mod = args.in[4]; const float* pre_mix_g = args.in[5]; const float* post_mix_g = args.in[6];
    const float* pre_mlp_g = args.in[7]; const float* post_mlp_g = args.in[8]; const float* w_in = args.in[9]; const float* q_norm_g = args.in[10]; const float* kv_norm_g = args.in[11];
    const float* w_uq = args.in[12]; const float* w_ukv = args.in[13]; const float* hgrn_norm_g = args.in[14]; const float* lbl_f = args.in[15]; const float* lbl_b = args.in[16];
    const float* w_out = args.in[17]; const float* w_up = args.in[18]; const float* w_down = args.in[19];
    float* out = args.out;
    bf16* Win_t = (bf16*)(ws + WS_WIN); bf16* Wuq_t = (bf16*)(ws + WS_WUQ); bf16* Wukv_t = (bf16*)(ws + WS_WUKV); bf16* Wout_t = (bf16*)(ws + WS_WOUT); bf16* Wup_t = (bf16*)(ws + WS_WUP); bf16* Wdn_t = (bf16*)(ws + WS_WDN);
    float* mod = (float*)(ws + WS_MOD); float* cs = (float*)(ws + WS_CS); float* qss = (float*)(ws + WS_QSS); float* kvss = (float*)(ws + WS_KVSS); float* rss = (float*)(ws + WS_RSS);
    bf16* KR = (bf16*)(ws + WS_KR); bf16* XN = (bf16*)(ws + WS_XN); bf16* OF = (bf16*)(ws + WS_OF); bf16* OB = (bf16*)(ws + WS_OB); bf16* Y = (bf16*)(ws + WS_Y);
    bf16* HQ = (bf16*)(ws + WS_HQ); bf16* FF = (bf16*)(ws + WS_FF); bf16* FB = (bf16*)(ws + WS_FB); bf16* HI = (bf16*)(ws + WS_HI); bf16* HG = (bf16*)(ws + WS_HG);
    bf16* QN = (bf16*)(ws + WS_QN); bf16* QR = (bf16*)(ws + WS_QR); bf16* KN = (bf16*)(ws + WS_KN); bf16* V = (bf16*)(ws + WS_V); bf16* QL = (bf16*)(ws + WS_QL); bf16* KVL = (bf16*)(ws + WS_KVL);
    bf16* MIXIN = (bf16*)(ws + WS_MIXIN); bf16* MIX = (bf16*)(ws + WS_MIX); bf16* H = (bf16*)(ws + WS_H);

    if (IN(0)) {
        for (int u = C.vcu; u < NMOD / 64; u += C.G) {
            LAS float* condT = (LAS float*)(C.lds);
            LAS float* part = (LAS float*)(C.lds + 32768);
            for (int k = C.tid; k < DM; k += NWAVES * 64) {
#pragma unroll
                for (int b = 0; b < NB; ++b) { const float c = cin[b * DM + k]; condT[k * 4 + b] = c * sigmoidf_(c); } }
            __syncthreads();
            const int col = 64 * u + C.lane; f32x4 acc = {0.f, 0.f, 0.f, 0.f};
            const float* wp = w_mod + (size_t)(C.wave * 256) * NMOD + col;
#pragma unroll 8
            for (int k = 0; k < 256; ++k) { const float w = wp[(size_t)k * NMOD]; const f32x4 cv = *(const LAS f32x4*)(condT + (C.wave * 256 + k) * 4); acc += cv * w; }
#pragma unroll
            for (int b = 0; b < NB; ++b) part[(C.wave * 4 + b) * 64 + C.lane] = acc[b];
            __syncthreads();
            if (C.tid < 256) { const int b = C.tid >> 6, l = C.tid & 63; float s = b_mod[64 * u + l];
#pragma unroll
                for (int w = 0; w < 8; ++w) s += part[(w * 4 + b) * 64 + l];
                mod[b * NMOD + 64 * u + l] = s; }
            __syncthreads();
        }
        for (int idx = gw * 64 + C.lane; idx < M * 32; idx += NGW * 64) { const int row = idx >> 5, i = idx & 31;
            const float invf = powf(10000.0f, -(float)i * (1.0f / 32.0f)); const float ang = (float)positions[row] * invf;
            pg8::f32x2 v; v.x = cosf(ang); v.y = sinf(ang); *(pg8::f32x2*)(cs + (size_t)idx * 2) = v; }
        LAS float* scr = (LAS float*)(C.lds + RING_OFF + C.wave * 16384);
        constexpr int I_IN = (DM / 64) * (NIN / 32), I_UQ = (512 / 64) * (1536 / 32), I_UKV = (256 / 64) * (2048 / 32), I_OUT = (DM / 64) * (DM / 32), I_UP = (DM / 64) * (FFD / 32), I_DN = (FFD / 64) * (DM / 32);
        constexpr int NITEMS = I_IN + I_UQ + I_UKV + I_OUT + I_UP + I_DN;
        for (int it = gw; it < NITEMS; it += NGW) {
            int r = it;
            if (r < I_IN) { transpose_item<1>(w_in, DM, NIN_SRC, NIN, nullptr, Win_t, scr, r, C.lane); continue; } r -= I_IN;
            if (r < I_UQ) { transpose_item<2>(w_uq, 512, 1536, 1536, q_norm_g, Wuq_t, scr, r, C.lane); continue; } r -= I_UQ;
            if (r < I_UKV) { transpose_item<0>(w_ukv, 256, 2048, 2048, kv_norm_g, Wukv_t, scr, r, C.lane); continue; } r -= I_UKV;
            if (r < I_OUT) { transpose_item<0>(w_out, DM, DM, DM, nullptr, Wout_t, scr, r, C.lane); continue; } r -= I_OUT;
            if (r < I_UP) { transpose_item<0>(w_up, DM, FFD, FFD, nullptr, Wup_t, scr, r, C.lane); continue; } r -= I_UP;
            transpose_item<0>(w_down, FFD, DM, DM, nullptr, Wdn_t, scr, r, C.lane);
        }
        if (BOTH(0)) GRID_BAR();
    }
    if (IN(1)) {
        for (int r = gw; r < M; r += NGW) { const int b = r / SEQ; const float* mb = mod + b * NMOD;
            const GAS f32x4* xr = (const GAS f32x4*)(x + (size_t)r * DM) + C.lane; f32x4 v[8]; float s = 0.f;
#pragma unroll
            for (int j = 0; j < 8; ++j) { v[j] = xr[64 * j]; s += (v[j].x * v[j].x + v[j].y * v[j].y) + (v[j].z * v[j].z + v[j].w * v[j].w); }
            const float rstd = 1.0f / sqrtf(wave_sum(s) * (1.0f / DM) + 1e-6f);
            GAS unsigned long long* o8 = (GAS unsigned long long*)(XN + (size_t)r * DM) + C.lane;
#pragma unroll
            for (int j = 0; j < 8; ++j) { const int c0 = 4 * C.lane + 256 * j; const f32x4 g = *(const f32x4*)(pre_mix_g + c0), sh = *(const f32x4*)(mb + c0), sc = *(const f32x4*)(mb + DM + c0);
                const f32x4 h = v[j] * rstd * g * (sc + 1.0f) + sh;
                o8[64 * j] = (unsigned long long)pk2(h.x, h.y) | ((unsigned long long)pk2(h.z, h.w) << 32); } }
        if (BOTH(1)) GRID_BAR();
    }
    if (IN(2)) {
        pg8::Gemm g{XN, Win_t, M, NIN, DM}; pg8::StaticOrder S; S.init(M, NIN, C.G, (int)blockIdx.x);
        pg8::EpiProj E{QL, KVL, HQ, FF, FB, HI, HG, KR, qss, kvss, cs};
        pg8::gemm_phase<pg8::EpiProj, pg8::StaticOrder, PG8_ALIGN, PG8_SP2>(C.lds + RING_OFF, g, S, E);
        if (BOTH(2)) GRID_BAR();
    }
    if (IN(3)) {
        { pg8::Gemm g{QL, Wuq_t, M, 1536, 512}; pg8::StaticOrder S; S.init(M, 1536, C.G, (int)blockIdx.x);
          pg8::EpiQ E{QN, QR, qss, cs};
          pg8::gemm_phase<pg8::EpiQ, pg8::StaticOrder, PG8_ALIGN, PG8_SP2>(C.lds + RING_OFF, g, S, E); }
        { pg8::Gemm g{KVL, Wukv_t, M, 2048, 256}; pg8::StaticOrder S; S.init(M, 2048, C.G, (int)blockIdx.x);
          pg8::EpiKV E{KN, V, kvss};
          pg8::gemm_phase<pg8::EpiKV, pg8::StaticOrder, PG8_ALIGN, PG8_SP2>(C.lds + RING_OFF, g, S, E); }
        if (BOTH(3)) GRID_BAR();
    }
    if (IN(4) || (((PH_MASK >> 11) & 1) && lo <= 4 && 4 < hi)) {
        if ((PH_MASK >> 4) & 1) { const att::Tens T{(const short*)QN, (const short*)QR, (const short*)KN, (const short*)KR, (const short*)V, (unsigned short*)MIXIN};
          const int per = (512 + C.G - 1) / C.G;
          for (int i = 0; i < per; ++i) { const int id = C.vcu * per + i; if (id >= 512) break; const int bh = id >> 4, qb = id & 15; att::attn_unit(bh >> 3, bh & 7, qb, T, (char*)lds + RING_OFF); } }
        if (((PH_MASK >> 11) & 1) && C.wave == 0) {
            for (int task = C.vcu; task < 128; task += C.G) {
                const int ch = task >> 1, eb = task & 1, b = ch >> 4, h = (ch >> 1) & 7, dir = ch & 1;
                const float* lbl = dir ? lbl_b : lbl_f; const bf16* FX = dir ? FB : FF; bf16* OD = dir ? OB : OF;
                float lb0, lb1; { const float a0 = lbl[h * 128 + C.lane], a1 = lbl[1024 + h * 128 + C.lane]; lb0 = 1.0f / (1.0f + __expf(a1 - a0));
                                  const float c0 = lbl[h * 128 + 64 + C.lane], c1 = lbl[1024 + h * 128 + 64 + C.lane]; lb1 = 1.0f / (1.0f + __expf(c1 - c0)); }
                float S[128];
#pragma unroll
                for (int d = 0; d < 128; ++d) S[d] = 0.f;
                const int e = eb * 64 + C.lane;
                size_t ro = ((size_t)b * SEQ + (dir ? SEQ - 1 : 0)) * 1024 + h * 128; const long step = dir ? -1024 : 1024;
                unsigned short nx0 = FX[ro + C.lane], nx1 = FX[ro + 64 + C.lane], nq0 = HQ[ro + C.lane], nq1 = HQ[ro + 64 + C.lane], nv = HI[ro + e];
                for (int t = 0; t < SEQ; ++t) {
                    const unsigned short x0 = nx0, x1 = nx1, q0 = nq0, q1 = nq1, vv = nv; const size_t rc = ro;
                    if (t + 1 < SEQ) { ro += step; nx0 = FX[ro + C.lane]; nx1 = FX[ro + 64 + C.lane]; nq0 = HQ[ro + C.lane]; nq1 = HQ[ro + 64 + C.lane]; nv = HI[ro + e]; }
                    const float f0 = lb0 + (1.0f - lb0) * sigmoidf_(bf2f(x0)), f1 = lb1 + (1.0f - lb1) * sigmoidf_(bf2f(x1));
                    const float k0 = 1.0f - f0, k1 = 1.0f - f1, qf0 = bf2f(q0), qf1 = bf2f(q1), v = bf2f(vv);
                    float o = 0.f;
#pragma unroll
                    for (int d = 0; d < 128; ++d) {
                        const float fd = __builtin_bit_cast(float, __builtin_amdgcn_readlane(__builtin_bit_cast(int, d < 64 ? f0 : f1), d & 63));
                        const float kd = __builtin_bit_cast(float, __builtin_amdgcn_readlane(__builtin_bit_cast(int, d < 64 ? k0 : k1), d & 63));
                        const float qd = __builtin_bit_cast(float, __builtin_amdgcn_readlane(__builtin_bit_cast(int, d < 64 ? qf0 : qf1), d & 63));
                        S[d] = fd * S[d] + kd * v; o += qd * S[d]; }
                    OD[rc + e] = (bf16)f2bf(o);
                }
            }
        }
        if (BOTH(4)) GRID_BAR();
    }
    if (IN(5)) {
        for (int r = gw; r < M; r += NGW) { const size_t o16 = (size_t)r * 1024 + 16 * C.lane;
            const v4u a0 = *(const GAS v4u*)(OF + o16), a1 = *(const GAS v4u*)(OF + o16 + 8), b0 = *(const GAS v4u*)(OB + o16), b1 = *(const GAS v4u*)(OB + o16 + 8);
            const v4u g0 = *(const GAS v4u*)(HG + o16), g1 = *(const GAS v4u*)(HG + o16 + 8);
            float sv[16]; float ss = 0.f;
#pragma unroll
            for (int i = 0; i < 4; ++i) { sv[2 * i] = bflo(a0[i]) + bflo(b0[i]); sv[2 * i + 1] = bfhi(a0[i]) + bfhi(b0[i]); sv[8 + 2 * i] = bflo(a1[i]) + bflo(b1[i]); sv[8 + 2 * i + 1] = bfhi(a1[i]) + bfhi(b1[i]); }
#pragma unroll
            for (int i = 0; i < 16; ++i) ss += sv[i] * sv[i];
            ss += __shfl_xor(ss, 1); ss += __shfl_xor(ss, 2); ss += __shfl_xor(ss, 4);
            const float rstd = 1.0f / sqrtf(ss * (1.0f / 128.0f) + 1e-6f);
            const float* gp = hgrn_norm_g + ((16 * C.lane) & 127); float ov[16];
#pragma unroll
            for (int i = 0; i < 4; ++i) { const float h0 = bflo(g0[i]), h1 = bfhi(g0[i]), h2 = bflo(g1[i]), h3 = bfhi(g1[i]);
                ov[2 * i] = sv[2 * i] * rstd * gp[2 * i] * (h0 * sigmoidf_(h0)); ov[2 * i + 1] = sv[2 * i + 1] * rstd * gp[2 * i + 1] * (h1 * sigmoidf_(h1));
                ov[8 + 2 * i] = sv[8 + 2 * i] * rstd * gp[8 + 2 * i] * (h2 * sigmoidf_(h2)); ov[8 + 2 * i + 1] = sv[8 + 2 * i + 1] * rstd * gp[8 + 2 * i + 1] * (h3 * sigmoidf_(h3)); }
            v4u w0, w1;
#pragma unroll
            for (int i = 0; i < 4; ++i) { w0[i] = pk2(ov[2 * i], ov[2 * i + 1]); w1[i] = pk2(ov[8 + 2 * i], ov[8 + 2 * i + 1]); }
            bf16* op = MIXIN + (size_t)r * 2048 + 1024 + 16 * C.lane; *(GAS v4u*)op = w0; *(GAS v4u*)(op + 8) = w1; }
        if (BOTH(5)) GRID_BAR();
    }
    if (IN(6)) {
        pg8::Gemm g{MIXIN, Wout_t, M, DM, DM}; pg8::StaticOrder S; S.init(M, DM, C.G, (int)blockIdx.x);
        pg8::EpiOut<0, true> E{MIX, DM, rss};
        pg8::gemm_phase<pg8::EpiOut<0, true>, pg8::StaticOrder, PG8_ALIGN, PG8_SP2>(C.lds + RING_OFF, g, S, E);
        if (BOTH(6)) GRID_BAR();
    }
    if (IN(7)) {
        for (int r = gw; r < M; r += NGW) { const int b = r / SEQ; const float* mb = mod + b * NMOD;
            const float sm = wave_sum(C.lane < 32 ? rss[(size_t)r * 32 + C.lane] : 0.f); const float rstd_m = 1.0f / sqrtf(sm * (1.0f / DM) + 1e-6f);
            const GAS f32x4* xr = (const GAS f32x4*)(x + (size_t)r * DM) + C.lane; const GAS unsigned long long* mr = (const GAS unsigned long long*)(MIX + (size_t)r * DM) + C.lane;
            GAS f32x4* orow = (GAS f32x4*)(out + (size_t)r * DM) + C.lane;
            f32x4 v[8]; float s = 0.f;
#pragma unroll
            for (int j = 0; j < 8; ++j) { const int c0 = 4 * C.lane + 256 * j; const unsigned long long mw = mr[64 * j]; const unsigned lo_ = (unsigned)mw, hi_ = (unsigned)(mw >> 32);
                const f32x4 mx = {bflo(lo_), bfhi(lo_), bflo(hi_), bfhi(hi_)}; const f32x4 g = *(const f32x4*)(post_mix_g + c0), ga = *(const f32x4*)(mb + 2 * DM + c0);
                v[j] = xr[64 * j] + ga * (mx * rstd_m * g); orow[64 * j] = v[j];
                s += (v[j].x * v[j].x + v[j].y * v[j].y) + (v[j].z * v[j].z + v[j].w * v[j].w); }
            const float rstd = 1.0f / sqrtf(wave_sum(s) * (1.0f / DM) + 1e-6f);
            GAS unsigned long long* o8 = (GAS unsigned long long*)(XN + (size_t)r * DM) + C.lane;
#pragma unroll
            for (int j = 0; j < 8; ++j) { const int c0 = 4 * C.lane + 256 * j; const f32x4 g = *(const f32x4*)(pre_mlp_g + c0), sh = *(const f32x4*)(mb + 3 * DM + c0), sc = *(const f32x4*)(mb + 4 * DM + c0);
                const f32x4 h = v[j] * rstd * g * (sc + 1.0f) + sh;
                o8[64 * j] = (unsigned long long)pk2(h.x, h.y) | ((unsigned long long)pk2(h.z, h.w) << 32); } }
        if (BOTH(7)) GRID_BAR();
    }
    if (IN(8)) {
        pg8::Gemm g{XN, Wup_t, M, FFD, DM}; pg8::StaticOrder S; S.init(M, FFD, C.G, (int)blockIdx.x);
        pg8::EpiOut<1, false> E{H, FFD, nullptr};
        pg8::gemm_phase<pg8::EpiOut<1, false>, pg8::StaticOrder, PG8_ALIGN, PG8_SP2>(C.lds + RING_OFF, g, S, E);
        if (BOTH(8)) GRID_BAR();
    }
    if (IN(9)) {
        pg8::Gemm g{H, Wdn_t, M, DM, FFD}; pg8::StaticOrder S; S.init(M, DM, C.G, (int)blockIdx.x);
        pg8::EpiOut<0, true> E{Y, DM, rss};
        pg8::gemm_phase<pg8::EpiOut<0, true>, pg8::StaticOrder, PG8_ALIGN, PG8_SP2>(C.lds + RING_OFF, g, S, E);
        if (BOTH(9)) GRID_BAR();
    }
    if (IN(10)) {
        for (int r = gw; r < M; r += NGW) { const int b = r / SEQ; const float* mb = mod + b * NMOD;
            const float sm = wave_sum(C.lane < 32 ? rss[(size_t)r * 32 + C.lane] : 0.f); const float rstd_y = 1.0f / sqrtf(sm * (1.0f / DM) + 1e-6f);
            const GAS unsigned long long* yr = (const GAS unsigned long long*)(Y + (size_t)r * DM) + C.lane; GAS f32x4* orow = (GAS f32x4*)(out + (size_t)r * DM) + C.lane;
#pragma unroll
            for (int j = 0; j < 8; ++j) { const int c0 = 4 * C.lane + 256 * j; const unsigned long long yw = yr[64 * j]; const unsigned lo_ = (unsigned)yw, hi_ = (unsigned)(yw >> 32);
                const f32x4 yx = {bflo(lo_), bfhi(lo_), bflo(hi_), bfhi(hi_)}; const f32x4 g = *(const f32x4*)(post_mlp_g + c0), gm = *(const f32x4*)(mb + 5 * DM + c0);
                orow[64 * j] = orow[64 * j] + gm * (yx * rstd_y * g); } }
    }
#undef IN
#undef BOTH
#undef GRID_BAR
}

extern "C" void kernel_launch(void* const* d_in, const int* in_sizes, int n_in, void* d_out, int out_size, void* d_ws, size_t ws_size, hipStream_t stream) {
    static int grid = 0;
    if (grid == 0) {
        if (n_in != 20 || in_sizes[0] != M * DM || out_size != M * DM || ws_size < WS_END) { fprintf(stderr, "kernel_launch: unexpected shapes: n_in %d in0 %d out %d ws %zu (need %zu)\n", n_in, n_in > 0 ? in_sizes[0] : -1, out_size, ws_size, (size_t)WS_END); grid = -1; return; }
        int dev = 0, cus = 0;
        if (hipGetDevice(&dev) != hipSuccess || hipDeviceGetAttribute(&cus, hipDeviceAttributeMultiprocessorCount, dev) != hipSuccess) { fprintf(stderr, "kernel_launch: device query failed\n"); grid = -1; return; }
        if (hipFuncSetAttribute((const void*)mk_fwd, hipFuncAttributeMaxDynamicSharedMemorySize, LDS_BYTES) != hipSuccess) { fprintf(stderr, "kernel_launch: hipFuncSetAttribute failed\n"); grid = -1; return; }
        int per_cu = 0;
        if (hipOccupancyMaxActiveBlocksPerMultiprocessor(&per_cu, (const void*)mk_fwd, NWAVES * 64, LDS_BYTES) != hipSuccess || per_cu < 1) fprintf(stderr, "kernel_launch: note: occupancy query reports %d workgroups per CU\n", per_cu);
        (void)hipGetLastError();
        grid = cus;
    }
    if (grid < 0) return;
    if (hipMemsetAsync((char*)d_ws + WS_CTL, 0, CTL_ZERO_BYTES, stream) != hipSuccess) { fprintf(stderr, "kernel_launch: memset failed\n"); return; }
    Args a{};
    for (int i = 0; i < 20; ++i) a.in[i] = (const float*)d_in[i];
    a.out = (float*)d_out; a.ws = (unsigned char*)d_ws;
    for (int li = 0; li < N_LAUNCHES; ++li) {
        a.ph_lo = (N_LAUNCHES == 1) ? 0 : li; a.ph_hi = (N_LAUNCHES == 1) ? NPH : li + 1;
        hipLaunchKernelGGL(mk_fwd, dim3(grid), dim3(NWAVES * 64), LDS_BYTES, stream, a);
        const hipError_t le = hipPeekAtLastError();
        if (le != hipSuccess) { fprintf(stderr, "kernel_launch: launch %d failed: %s\n", li, hipGetErrorName(le)); break; }
    }
}
```

```cpp
#include <hip/hip_runtime.h>
#include <hip/hip_bf16.h>
#include <cstdio>
#include <cstdint>
#include <cmath>
namespace pg8 {
#define PG8_LAS __attribute__((address_space(3)))
typedef unsigned short bf16_t;
typedef short bf16x8 __attribute__((ext_vector_type(8)));
typedef float f32x4 __attribute__((ext_vector_type(4)));
typedef unsigned u32x4 __attribute__((ext_vector_type(4)));
constexpr int BM = 256, BK = 64, HALF = 128, HTB = HALF * BK * 2  , STAGE_BYTES = 8 * HTB, NXCD = 8, WGM = 8;

__host__ __device__ __forceinline__ int lds_byte(int r, int c) { const int st = (r >> 4) * 2 + (c >> 5), rr = r & 15, cc = c & 31, ob = rr * 64 + cc * 2; return st * 1024 + (ob ^ (((ob >> 9) & 1) << 5)); }
__host__ __device__ __forceinline__ void stage_rc(int b, int& R, int& C) { const int st = b / 1024, sb = b % 1024, swz = sb ^ (((sb >> 9) & 1) << 5); R = (st >> 1) * 16 + swz / 64; C = (st & 1) * 32 + (swz % 64) / 2; }
__host__ __device__ __forceinline__ int perm32(int rho) { const int n = rho >> 4, i = rho & 15; return 8 * (i >> 2) + 4 * n + (i & 3); }

struct Unit { int pm, pn; };
struct Gemm { const bf16_t* A; const bf16_t* Bt; int M, N, K; };

struct StaticOrder {
    int nM, nN, nwg, G, c;
    __host__ __device__ void init(int M, int N, int G_, int c_) { nM = M / BM; nN = N / BM; nwg = nM * nN; G = G_; c = c_; }
    __host__ __device__ bool next(int i, Unit& u) const {
        const long L = (long)i * G + c; if (L >= nwg) return false;
        int wgid = (int)L; { const int q = nwg / NXCD, r = nwg % NXCD, xcd = wgid % NXCD, off = wgid / NXCD; wgid = (xcd < r ? xcd * (q + 1) : r * (q + 1) + (xcd - r) * q) + off; }
        const int nig = WGM * nN, gid = wgid / nig, fm = gid * WGM, gsz = (nM - fm) < WGM ? (nM - fm) : WGM;
        u.pm = fm + ((wgid % nig) % gsz); u.pn = (wgid % nig) / gsz; return true;
    }
    __device__ __forceinline__ void a_ready(const Unit&) const {}
    __device__ __forceinline__ void done(const Unit&) const {}
};

typedef float f32x2c_t __attribute__((ext_vector_type(2))); typedef __bf16 bf16x2c_t __attribute__((ext_vector_type(2)));
__device__ __forceinline__ unsigned cvt_pk_bf16(float lo, float hi) { f32x2c_t v = {lo, hi}; bf16x2c_t bb = __builtin_convertvector(v, bf16x2c_t); return __builtin_bit_cast(unsigned, bb); }
typedef float f32x2 __attribute__((ext_vector_type(2)));
__device__ __forceinline__ u32x4 pack8(const f32x4 a, const f32x4 b) { u32x4 w; w.x = cvt_pk_bf16(a[0], a[1]); w.y = cvt_pk_bf16(a[2], a[3]); w.z = cvt_pk_bf16(b[0], b[1]); w.w = cvt_pk_bf16(b[2], b[3]); return w; }
__device__ __forceinline__ void rope8(f32x4& a, f32x4& b, const float* csp) {
    const f32x4 c0 = *(const f32x4*)csp, c1 = *(const f32x4*)(csp + 4);
    f32x4 ra, rb;
    ra[0] = a[0] * c0[0] - a[1] * c0[1]; ra[1] = a[0] * c0[1] + a[1] * c0[0];
    ra[2] = a[2] * c0[2] - a[3] * c0[3]; ra[3] = a[2] * c0[3] + a[3] * c0[2];
    rb[0] = b[0] * c1[0] - b[1] * c1[1]; rb[1] = b[0] * c1[1] + b[1] * c1[0];
    rb[2] = b[2] * c1[2] - b[3] * c1[3]; rb[3] = b[2] * c1[3] + b[3] * c1[2];
    a = ra; b = rb;
}
__device__ __forceinline__ float sq4(const f32x4 x) { return (x[0] * x[0] + x[1] * x[1]) + (x[2] * x[2] + x[3] * x[3]); }
constexpr float NORM_EPS = 1e-6f;

struct EpiProj {
    static constexpr bool PERM = true, AFTER_DRAIN = false;
    bf16_t *QL, *KVL, *HQ, *FF, *FB, *HI, *HG, *KR; float *qss, *kvss; const float* cs;
    __device__ __forceinline__ void operator()(const f32x4 (&acc)[2][2][4][2], const Unit& u, int wr, int wc, int fr, int fq) const {
        const int pn = u.pn, row0 = u.pm * BM + wr * 64 + fr, cl = wc * 32 + 8 * fq;
        if (pn == 23) {
            if (wc < 2) {
#pragma unroll
                for (int ai = 0; ai < 2; ++ai)
#pragma unroll
                    for (int m = 0; m < 4; ++m) { const int row = row0 + ai * HALF + m * 16; f32x4 a = acc[ai][0][m][0], b = acc[ai][0][m][1];
                        rope8(a, b, cs + (size_t)row * 64 + cl); *(u32x4*)(KR + (size_t)row * 64 + cl) = pack8(a, b); }
            }
            return;
        }
        bf16_t* base; int ldc, col;
        if (pn < 2) { base = QL; ldc = 512; col = pn * 256; }
        else if (pn == 2) { base = KVL; ldc = 256; col = 0; }
        else { const int s = (pn - 3) >> 2; base = s == 0 ? HQ : s == 1 ? FF : s == 2 ? FB : s == 3 ? HI : HG; ldc = 1024; col = ((pn - 3) & 3) * 256; }
#pragma unroll
        for (int ai = 0; ai < 2; ++ai)
#pragma unroll
            for (int m = 0; m < 4; ++m) { bf16_t* rowp = base + (size_t)(row0 + ai * HALF + m * 16) * ldc + col + cl;
#pragma unroll
                for (int bj = 0; bj < 2; ++bj) *(u32x4*)(rowp + bj * HALF) = pack8(acc[ai][bj][m][0], acc[ai][bj][m][1]); }
        if (pn <= 2) {
#pragma unroll
            for (int ai = 0; ai < 2; ++ai)
#pragma unroll
                for (int m = 0; m < 4; ++m) { float s = (sq4(acc[ai][0][m][0]) + sq4(acc[ai][0][m][1])) + (sq4(acc[ai][1][m][0]) + sq4(acc[ai][1][m][1]));
                    s += __shfl_xor(s, 16); s += __shfl_xor(s, 32);
                    const int row = row0 + ai * HALF + m * 16;
                    if (fq == 0) { if (pn < 2) qss[(size_t)row * 8 + pn * 4 + wc] = s; else kvss[(size_t)row * 4 + wc] = s; } }
        }
    }
};
struct EpiQ {
    static constexpr bool PERM = true, AFTER_DRAIN = false;
    bf16_t *QN, *QR; const float* qss; const float* cs;
    __device__ __forceinline__ void operator()(const f32x4 (&acc)[2][2][4][2], const Unit& u, int wr, int wc, int fr, int fq) const {
        const int pn = u.pn, row0 = u.pm * BM + wr * 64 + fr, cl = wc * 32 + 8 * fq;
#pragma unroll
        for (int ai = 0; ai < 2; ++ai)
#pragma unroll
            for (int m = 0; m < 4; ++m) { const int row = row0 + ai * HALF + m * 16;
                const f32x4 s0 = *(const f32x4*)(qss + (size_t)row * 8), s1 = *(const f32x4*)(qss + (size_t)row * 8 + 4);
                const float rstd = 1.0f / sqrtf((((s0[0] + s0[1]) + (s0[2] + s0[3])) + ((s1[0] + s1[1]) + (s1[2] + s1[3]))) * (1.0f / 512.0f) + NORM_EPS);
                if (pn < 4) {
#pragma unroll
                    for (int bj = 0; bj < 2; ++bj) *(u32x4*)(QN + (size_t)row * 1024 + pn * 256 + bj * HALF + cl) = pack8(acc[ai][bj][m][0] * rstd, acc[ai][bj][m][1] * rstd);
                } else {
#pragma unroll
                    for (int bj = 0; bj < 2; ++bj) { f32x4 a = acc[ai][bj][m][0] * rstd, b = acc[ai][bj][m][1] * rstd;
                        rope8(a, b, cs + (size_t)row * 64 + (cl & 63)); *(u32x4*)(QR + (size_t)row * 512 + (pn - 4) * 256 + bj * HALF + cl) = pack8(a, b); }
                } }
    }
};
struct EpiKV {
    static constexpr bool PERM = true, AFTER_DRAIN = false;
    bf16_t *KN, *V; const float* kvss;
    __device__ __forceinline__ void operator()(const f32x4 (&acc)[2][2][4][2], const Unit& u, int wr, int wc, int fr, int fq) const {
        const int pn = u.pn, row0 = u.pm * BM + wr * 64 + fr, cl = wc * 32 + 8 * fq;
#pragma unroll
        for (int ai = 0; ai < 2; ++ai)
#pragma unroll
            for (int m = 0; m < 4; ++m) { const int row = row0 + ai * HALF + m * 16;
                const f32x4 s0 = *(const f32x4*)(kvss + (size_t)row * 4);
                const float rstd = 1.0f / sqrtf(((s0[0] + s0[1]) + (s0[2] + s0[3])) * (1.0f / 256.0f) + NORM_EPS);
                *(u32x4*)(KN + (size_t)row * 1024 + pn * HALF + cl) = pack8(acc[ai][0][m][0] * rstd, acc[ai][0][m][1] * rstd);
                *(u32x4*)(V + (size_t)row * 1024 + pn * HALF + cl) = pack8(acc[ai][1][m][0] * rstd, acc[ai][1][m][1] * rstd); }
    }
};
template <int ACT  , bool SS> struct EpiOut {
    static constexpr bool PERM = true, AFTER_DRAIN = false;
    bf16_t* O; int ldc; float* ss;
    __device__ __forceinline__ void operator()(const f32x4 (&acc)[2][2][4][2], const Unit& u, int wr, int wc, int fr, int fq) const {
        const int pn = u.pn, row0 = u.pm * BM + wr * 64 + fr, cl = wc * 32 + 8 * fq;
#pragma unroll
        for (int ai = 0; ai < 2; ++ai)
#pragma unroll
            for (int m = 0; m < 4; ++m) { const int row = row0 + ai * HALF + m * 16; bf16_t* rowp = O + (size_t)row * ldc + pn * BM + cl;
#pragma unroll
                for (int bj = 0; bj < 2; ++bj) { f32x4 a = acc[ai][bj][m][0], b = acc[ai][bj][m][1];
                    if (ACT == 1) { a = __builtin_elementwise_max(a, (f32x4){0.f, 0.f, 0.f, 0.f}); b = __builtin_elementwise_max(b, (f32x4){0.f, 0.f, 0.f, 0.f}); a = a * a; b = b * b; }
                    *(u32x4*)(rowp + bj * HALF) = pack8(a, b); }
                if (SS) { float s = (sq4(acc[ai][0][m][0]) + sq4(acc[ai][0][m][1])) + (sq4(acc[ai][1][m][0]) + sq4(acc[ai][1][m][1]));
                    s += __shfl_xor(s, 16); s += __shfl_xor(s, 32);
                    if (fq == 0) ss[(size_t)row * 32 + pn * 4 + wc] = s; } }
    }
};
template <class Epi, class Sched, bool ALIGN_EPI = false, bool SP2 = false>
__device__ __forceinline__ void gemm_phase(PG8_LAS unsigned char* lds, const Gemm g, const Sched& S, const Epi& E) {
    const int tid = threadIdx.x, wid = __builtin_amdgcn_readfirstlane(tid >> 6), lane = tid & 63, wr = wid >> 2, wc = wid & 3, fr = lane & 15, fq = lane >> 4;
    const int K = g.K, nt = K / BK;
    unsigned voffA[2], voffB[2];
#pragma unroll
    for (int i = 0; i < 2; ++i) { int R, C; stage_rc(tid * 16 + i * 8192, R, C); const int Rb = Epi::PERM ? ((R & ~31) + perm32(R & 31)) : R;
        voffA[i] = (unsigned)(R * K + C) * 2u; voffB[i] = (unsigned)(Rb * K + C) * 2u; }
    const size_t kstep = (size_t)(BK * 2);
    const size_t hstep = (size_t)HALF * K * 2;
    const size_t tstep = 2 * hstep;
    const unsigned ldsw = (unsigned)wid * 1024u;
    const int aoff = lds_byte(wr * 64 + fr, fq * 8), boff = lds_byte(wc * 32 + fr, fq * 8);
#define PG8_SA(b, h) (((b) * 2 + (h)) * HTB)
#define PG8_SB(b, h) ((4 + (b) * 2 + (h)) * HTB)
#define PG8_STAGE(bufoff, gbase, voff) do { _Pragma("unroll") for (int _i = 0; _i < 2; ++_i) \
        __builtin_amdgcn_global_load_lds((const unsigned*)((const char*)(gbase) + (voff)[_i]), (PG8_LAS unsigned*)(lds + (bufoff) + ldsw + _i * 8192), 16, 0, 0); } while (0)
#define PG8_LDA(dst, b, h) do { _Pragma("unroll") for (int m = 0; m < 4; ++m) _Pragma("unroll") for (int k = 0; k < 2; ++k) dst[m][k] = *(const PG8_LAS bf16x8*)(lds + PG8_SA(b, h) + aoff + m * 2048 + k * 1024); } while (0)
#define PG8_LDB(dst, b, h) do { _Pragma("unroll") for (int n = 0; n < 2; ++n) _Pragma("unroll") for (int k = 0; k < 2; ++k) dst[n][k] = *(const PG8_LAS bf16x8*)(lds + PG8_SB(b, h) + boff + n * 2048 + k * 1024); } while (0)
#define PG8_MMA(ai, bj, At, Bt) do { __builtin_amdgcn_s_setprio(1); _Pragma("unroll") for (int m = 0; m < 4; ++m) _Pragma("unroll") for (int n = 0; n < 2; ++n) _Pragma("unroll") for (int k = 0; k < 2; ++k) \
        acc[ai][bj][m][n] = __builtin_amdgcn_mfma_f32_16x16x32_bf16(Bt[n][k], At[m][k], acc[ai][bj][m][n], 0, 0, 0); __builtin_amdgcn_s_setprio(0); } while (0)
#define PG8_WAIT_V(n) asm volatile("s_waitcnt vmcnt(" #n ")" ::: "memory")
#define PG8_WAIT_L(n) asm volatile("s_waitcnt lgkmcnt(" #n ")" ::: "memory")
#define PG8_BAR __builtin_amdgcn_s_barrier()
#define PG8_SCHED __builtin_amdgcn_sched_barrier(0)
    Unit cur, nxt; int ui = 0;
    if (!S.next(0, cur)) return;
    f32x4 acc[2][2][4][2];
#pragma unroll
    for (int a = 0; a < 2; ++a)
#pragma unroll
        for (int b = 0; b < 2; ++b)
#pragma unroll
            for (int m = 0; m < 4; ++m)
#pragma unroll
                for (int n = 0; n < 2; ++n) acc[a][b][m][n] = (f32x4){0.f, 0.f, 0.f, 0.f};
    bf16x8 At[4][2], B0[2][2], B1[2][2];
    const char* cA = (const char*)g.A + (size_t)cur.pm * tstep; const char* cB = (const char*)g.Bt + (size_t)cur.pn * tstep;
    S.a_ready(cur);
    if constexpr (SP2) {
        PG8_STAGE(PG8_SB(0, 0), cB, voffB); PG8_STAGE(PG8_SB(0, 1), cB + hstep, voffB); PG8_STAGE(PG8_SA(0, 0), cA, voffA); PG8_STAGE(PG8_SA(0, 1), cA + hstep, voffA);
        if (wr == 1) PG8_BAR;
        PG8_WAIT_V(2); PG8_BAR;
        PG8_STAGE(PG8_SB(1, 0), cB + kstep, voffB); PG8_STAGE(PG8_SA(1, 0), cA + kstep, voffA); PG8_STAGE(PG8_SB(1, 1), cB + hstep + kstep, voffB);
        PG8_WAIT_V(6); PG8_BAR;
    } else {
        PG8_STAGE(PG8_SB(0, 0), cB, voffB); PG8_STAGE(PG8_SA(0, 0), cA, voffA); PG8_STAGE(PG8_SB(0, 1), cB + hstep, voffB); PG8_STAGE(PG8_SA(0, 1), cA + hstep, voffA);
        if (wr == 1) PG8_BAR;
        PG8_WAIT_V(4); PG8_BAR;
        PG8_STAGE(PG8_SB(1, 0), cB + kstep, voffB); PG8_STAGE(PG8_SA(1, 0), cA + kstep, voffA); PG8_STAGE(PG8_SB(1, 1), cB + hstep + kstep, voffB);
        PG8_WAIT_V(6); PG8_BAR;
    }
    for (;;) {
        const bool has_next = S.next(ui + 1, nxt);
        const char* nA = has_next ? (const char*)g.A + (size_t)nxt.pm * tstep : cA; const char* nB = has_next ? (const char*)g.Bt + (size_t)nxt.pn * tstep : cB;
        for (int t = 0; t < nt; t += 2) {
            const bool last = (t == nt - 2);
            const char* a1 = cA + (size_t)(t + 1) * kstep;
            const char* a2 = last ? nA : cA + (size_t)(t + 2) * kstep; const char* b2 = last ? nB : cB + (size_t)(t + 2) * kstep;
            const char* a3 = a2 + kstep; const char* b3 = b2 + kstep;
            if (last && has_next) S.a_ready(nxt);
            if constexpr (SP2) {
            PG8_LDB(B0, 0, 0); PG8_LDB(B1, 0, 1); PG8_SCHED; PG8_LDA(At, 0, 0); PG8_STAGE(PG8_SA(1, 1), a1 + hstep, voffA);
            PG8_WAIT_V(8); PG8_WAIT_L(0); PG8_BAR; PG8_MMA(0, 0, At, B0); PG8_MMA(0, 1, At, B1); PG8_BAR; PG8_SCHED;
            PG8_LDA(At, 0, 1); PG8_STAGE(PG8_SB(0, 0), b2, voffB); PG8_STAGE(PG8_SB(0, 1), b2 + hstep, voffB); PG8_STAGE(PG8_SA(0, 0), a2, voffA);
            PG8_WAIT_V(8); PG8_WAIT_L(0); PG8_BAR; PG8_MMA(1, 0, At, B0); PG8_MMA(1, 1, At, B1); PG8_BAR; PG8_SCHED;
            PG8_LDB(B0, 1, 0); PG8_LDB(B1, 1, 1); PG8_SCHED; PG8_LDA(At, 1, 0); PG8_STAGE(PG8_SA(0, 1), a2 + hstep, voffA);
            PG8_WAIT_V(8); PG8_WAIT_L(0); PG8_BAR; PG8_MMA(0, 0, At, B0); PG8_MMA(0, 1, At, B1); PG8_BAR; PG8_SCHED;
            PG8_LDA(At, 1, 1); PG8_STAGE(PG8_SB(1, 0), b3, voffB); PG8_STAGE(PG8_SB(1, 1), b3 + hstep, voffB); PG8_STAGE(PG8_SA(1, 0), a3, voffA);
            PG8_WAIT_V(8); PG8_WAIT_L(0); PG8_BAR; PG8_MMA(1, 0, At, B0); PG8_MMA(1, 1, At, B1); PG8_BAR; PG8_SCHED;
            } else {
            PG8_LDB(B0, 0, 0); PG8_SCHED; PG8_LDA(At, 0, 0); PG8_STAGE(PG8_SA(1, 1), a1 + hstep, voffA);
            PG8_WAIT_L(8); PG8_BAR; PG8_WAIT_L(0); PG8_MMA(0, 0, At, B0); PG8_BAR; PG8_SCHED;
            PG8_LDB(B1, 0, 1); PG8_STAGE(PG8_SB(0, 0), b2, voffB);
            PG8_BAR; PG8_WAIT_L(0); PG8_MMA(0, 1, At, B1); PG8_BAR;
            PG8_LDA(At, 0, 1); PG8_STAGE(PG8_SA(0, 0), a2, voffA);
            PG8_BAR; PG8_WAIT_L(0); PG8_MMA(1, 0, At, B0); PG8_BAR; PG8_SCHED;
            PG8_STAGE(PG8_SB(0, 1), b2 + hstep, voffB);
            PG8_WAIT_V(6); PG8_BAR; PG8_MMA(1, 1, At, B1); PG8_BAR;
            PG8_LDB(B0, 1, 0); PG8_SCHED; PG8_LDA(At, 1, 0); PG8_STAGE(PG8_SA(0, 1), a2 + hstep, voffA);
            PG8_WAIT_L(8); PG8_BAR; PG8_WAIT_L(0); PG8_MMA(0, 0, At, B0); PG8_BAR; PG8_SCHED;
            PG8_LDB(B1, 1, 1); PG8_STAGE(PG8_SB(1, 0), b3, voffB);
            PG8_BAR; PG8_WAIT_L(0); PG8_MMA(0, 1, At, B1); PG8_BAR;
            PG8_LDA(At, 1, 1); PG8_STAGE(PG8_SA(1, 0), a3, voffA);
            PG8_BAR; PG8_WAIT_L(0); PG8_MMA(1, 0, At, B0); PG8_BAR; PG8_SCHED;
            PG8_STAGE(PG8_SB(1, 1), b3 + hstep, voffB);
            PG8_WAIT_V(6); PG8_BAR; PG8_MMA(1, 1, At, B1); PG8_BAR;
            }
        }
        if constexpr (ALIGN_EPI) { if (wr == 0) PG8_BAR; }
        if constexpr (!Epi::AFTER_DRAIN) { E(acc, cur, wr, wc, fr, fq); S.done(cur); }
        if (!has_next) break;
#pragma unroll
        for (int a = 0; a < 2; ++a)
#pragma unroll
            for (int b = 0; b < 2; ++b)
#pragma unroll
                for (int m = 0; m < 4; ++m)
#pragma unroll
                    for (int n = 0; n < 2; ++n) acc[a][b][m][n] = (f32x4){0.f, 0.f, 0.f, 0.f};
        cur = nxt; cA = nA; cB = nB; ++ui;
        if constexpr (ALIGN_EPI) { if (wr == 1) PG8_BAR; }
    }
    PG8_WAIT_V(0);
    if constexpr (!ALIGN_EPI) { if (wr == 0) PG8_BAR; }
    PG8_BAR;
    if constexpr (Epi::AFTER_DRAIN) { E.fused(acc, cur, wr, wc, fr, fq, lds, wid, lane); S.done(cur); }
#undef PG8_SA
#undef PG8_SB
#undef PG8_STAGE
#undef PG8_LDA
#undef PG8_LDB
#undef PG8_MMA
#undef PG8_WAIT_V
#undef PG8_WAIT_L
#undef PG8_BAR
#undef PG8_SCHED
}
}
#define PG8_SP2 true
#define PG8_ALIGN true
namespace att {
using bf16x8 = __attribute__((ext_vector_type(8))) short;
using s16x4  = __attribute__((ext_vector_type(4))) short;
using f32x16 = __attribute__((ext_vector_type(16))) float;
using u32x4  = __attribute__((ext_vector_type(4))) unsigned;
constexpr int NW = 8, QBLK = 32, KVBLK = 64, SEQ = 4096;
constexpr float SCALE = 0.07216878364870322f;
constexpr float THR = 8.f;
#ifndef ATT_SDEPTH
#define ATT_SDEPTH 1
#endif
#ifndef QKT_SB
#define QKT_SB 0
#endif
constexpr int SDEPTH = ATT_SDEPTH;
constexpr int SHM_V = 16384, SHM_KN = 64 * 272, SHM_KR = 64 * 144;
constexpr int OFF_V = 0, OFF_KN = 2 * SHM_V, OFF_KR = OFF_KN + 2 * SHM_KN, OFF_WS = OFF_KR + 2 * SHM_KR, OFF_QR = OFF_WS + NW * 64 * 4, LDS_BYTES = OFF_QR + NW * 4096;
#define KSWZ(row, colB) ((row) * 272 + (colB))
#define KRSWZ(row, colB) ((row) * 144 + (colB))
#define SBAR() __builtin_amdgcn_sched_barrier(0)
__device__ __forceinline__ int crow(int r, int hi) { return (r & 3) + 8 * (r >> 2) + 4 * hi; }
__device__ __forceinline__ unsigned cvtpk(float lo, float hi) { unsigned r; asm volatile("v_cvt_pk_bf16_f32 %0, %1, %2" : "=v"(r) : "v"(lo), "v"(hi)); return r; }
__device__ __forceinline__ void partialSM(f32x16& p0, f32x16& p1, float& m_reg, float& mn, float& alpha) {
  constexpr float C = SCALE * 1.4426950408889634f;
  float pmax = p0[0]; for (int r = 1; r < 16; ++r) pmax = fmaxf(pmax, p0[r]); for (int r = 0; r < 16; ++r) pmax = fmaxf(pmax, p1[r]);
  { auto rr = __builtin_amdgcn_permlane32_swap(__float_as_uint(pmax), __float_as_uint(pmax), false, false);
    pmax = fmaxf(__uint_as_float(rr[0]), __uint_as_float(rr[1])); }
  if (__builtin_expect(__all(pmax - m_reg <= THR / SCALE), 1)) { mn = m_reg; alpha = 1.f; }
  else { mn = fmaxf(m_reg, pmax); alpha = __builtin_amdgcn_exp2f((m_reg - mn) * C); m_reg = mn; }
  float mnC = -mn * C;
  for (int r = 0; r < 16; ++r) p0[r] = fmaf(p0[r], C, mnC); for (int r = 0; r < 16; ++r) p1[r] = fmaf(p1[r], C, mnC);
  for (int r = 0; r < 16; ++r) p0[r] = __builtin_amdgcn_exp2f(p0[r]);
}
__device__ __forceinline__ void finishSM(f32x16& p0, f32x16& p1, float alpha, float& l_reg, bf16x8& pa0, bf16x8& pa1, bf16x8& pa2, bf16x8& pa3) {
  for (int r = 0; r < 16; ++r) p1[r] = __builtin_amdgcn_exp2f(p1[r]);
  float ps = 0; for (int r = 0; r < 16; ++r) ps += p0[r]; for (int r = 0; r < 16; ++r) ps += p1[r];
  { auto rr = __builtin_amdgcn_permlane32_swap(__float_as_uint(ps), __float_as_uint(ps), false, false);
    ps = __uint_as_float(rr[0]) + __uint_as_float(rr[1]); }
  l_reg = l_reg * alpha + ps;
#define PK4(P, BASE, OUT) do { unsigned a0 = cvtpk(P[BASE + 0], P[BASE + 1]), a1 = cvtpk(P[BASE + 2], P[BASE + 3]);   \
    unsigned b0 = cvtpk(P[BASE + 4], P[BASE + 5]), b1 = cvtpk(P[BASE + 6], P[BASE + 7]);                              \
    auto r0 = __builtin_amdgcn_permlane32_swap(a0, b0, false, false); auto r1 = __builtin_amdgcn_permlane32_swap(a1, b1, false, false); \
    u32x4 w = {r0[0], r1[0], r0[1], r1[1]}; OUT = *reinterpret_cast<bf16x8*>(&w); } while (0)
  PK4(p0, 0, pa0); PK4(p0, 8, pa1); PK4(p1, 0, pa2); PK4(p1, 8, pa3);
#undef PK4
}
__device__ __forceinline__ void qkt(f32x16& p0, f32x16& p1, const char* Kn, const char* Kr, const bf16x8* qr, const char* qrl, int r32, int hi) {
  p0 = f32x16{}; p1 = f32x16{};
#pragma unroll
  for (int d0 = 0; d0 < 8; ++d0) { const int cb = (d0 * 16 + hi * 8) * 2;
    const bf16x8 b0 = *reinterpret_cast<const bf16x8*>(Kn + KSWZ(r32, cb));
    const bf16x8 b1 = *reinterpret_cast<const bf16x8*>(Kn + KSWZ(32 + r32, cb));
    p0 = __builtin_amdgcn_mfma_f32_32x32x16_bf16(b0, qr[d0], p0, 0, 0, 0);
    p1 = __builtin_amdgcn_mfma_f32_32x32x16_bf16(b1, qr[d0], p1, 0, 0, 0);
    if (QKT_SB && (d0 & 3) == 3) SBAR(); }
#pragma unroll
  for (int d0 = 0; d0 < 4; ++d0) { const int cb = (d0 * 16 + hi * 8) * 2;
    const bf16x8 b0 = *reinterpret_cast<const bf16x8*>(Kr + KRSWZ(r32, cb));
    const bf16x8 b1 = *reinterpret_cast<const bf16x8*>(Kr + KRSWZ(32 + r32, cb));
    const bf16x8 qf = *reinterpret_cast<const bf16x8*>(qrl + d0 * 1024);
    p0 = __builtin_amdgcn_mfma_f32_32x32x16_bf16(b0, qf, p0, 0, 0, 0);
    p1 = __builtin_amdgcn_mfma_f32_32x32x16_bf16(b1, qf, p1, 0, 0, 0); }
}
__device__ __forceinline__ int v_st(int k, int c) { const int kk = (k & ~0xC) | ((k & 4) << 1) | ((k & 8) >> 1); return ((kk >> 3) * 4 + (c >> 5)) * 512 + ((kk & 7) * 32 + (c & 31)) * 2; }
__device__ __forceinline__ int v_rd_base(int lane) { return ((lane & 3) << 3) | (((lane >> 2) & 3) << 6) | (((lane >> 4) & 1) << 5) | (((lane >> 5) & 1) << 8); }
constexpr int v_rd_off(int d0, int ks, int half) { return d0 * 512 + ks * 4096 + half * 2048; }
template <int OFF> __device__ __forceinline__ s16x4 tr_read(int vb) {
  s16x4 r; asm volatile("ds_read_b64_tr_b16 %0, %1 offset:%2" : "=&v"(r) : "v"(vb), "i"(OFF) : "memory"); return r;
}
template <int D0> __device__ __forceinline__ void pv_one(f32x16& od, int vb, bf16x8 pa0, bf16x8 pa1, bf16x8 pa2, bf16x8 pa3) {
  const s16x4 l0 = tr_read<v_rd_off(D0, 0, 0)>(vb), h0 = tr_read<v_rd_off(D0, 0, 1)>(vb), l1 = tr_read<v_rd_off(D0, 1, 0)>(vb), h1 = tr_read<v_rd_off(D0, 1, 1)>(vb);
  const s16x4 l2 = tr_read<v_rd_off(D0, 2, 0)>(vb), h2 = tr_read<v_rd_off(D0, 2, 1)>(vb), l3 = tr_read<v_rd_off(D0, 3, 0)>(vb), h3 = tr_read<v_rd_off(D0, 3, 1)>(vb);
  asm volatile("s_waitcnt lgkmcnt(0)" ::: "memory"); SBAR();
#define PK(L, H) (bf16x8){L[0], L[1], L[2], L[3], H[0], H[1], H[2], H[3]}
  od = __builtin_amdgcn_mfma_f32_32x32x16_bf16(pa0, PK(l0, h0), od, 0, 0, 0);
  od = __builtin_amdgcn_mfma_f32_32x32x16_bf16(pa1, PK(l1, h1), od, 0, 0, 0);
  od = __builtin_amdgcn_mfma_f32_32x32x16_bf16(pa2, PK(l2, h2), od, 0, 0, 0);
  od = __builtin_amdgcn_mfma_f32_32x32x16_bf16(pa3, PK(l3, h3), od, 0, 0, 0);
#undef PK
}
__device__ __forceinline__ void pv_d0(f32x16* o, int vb, bf16x8 pa0, bf16x8 pa1, bf16x8 pa2, bf16x8 pa3) {
  pv_one<0>(o[0], vb, pa0, pa1, pa2, pa3); pv_one<1>(o[1], vb, pa0, pa1, pa2, pa3); pv_one<2>(o[2], vb, pa0, pa1, pa2, pa3); pv_one<3>(o[3], vb, pa0, pa1, pa2, pa3);
}
struct Tens { const short* QN; const short* QR; const short* KN; const short* KR; const short* V; unsigned short* O; };
__device__ __forceinline__ unsigned short f2bf_rne(float f) { unsigned u = __builtin_bit_cast(unsigned, f); return (unsigned short)((u + 0x7fffu + ((u >> 16) & 1u)) >> 16); }
__device__ __forceinline__ void attn_unit(int b, int h, int qb, const Tens& T, char* lds) {
  int tid = threadIdx.x; asm volatile("" : "+v"(tid));
  const int wid = tid >> 6, lane = tid & 63, r32 = lane & 31, hi = lane >> 5;
  char* V_lds = lds + OFF_V; char* KN_lds = lds + OFF_KN; char* KR_lds = lds + OFF_KR;
  char* qrl = lds + OFF_QR + wid * 4096 + lane * 16; float* ws = (float*)(lds + OFF_WS) + wid * 64; float* li_l = ws; float* al_l = ws + 32;
  float m_reg = -1e30f, l_reg = 0; f32x16 o[4] = {}; bf16x8 qr[8];
  const long rowbase = (long)b * SEQ, qrow = rowbase + qb * 256 + wid * QBLK + r32;
  { const short* Qn = T.QN + qrow * 1024 + h * 128 + hi * 8; const short* Qr = T.QR + qrow * 512 + h * 64 + hi * 8;
#pragma unroll
    for (int d0 = 0; d0 < 8; ++d0) qr[d0] = *reinterpret_cast<const bf16x8*>(Qn + d0 * 16);
#pragma unroll
    for (int d0 = 0; d0 < 4; ++d0) *reinterpret_cast<bf16x8*>(qrl + d0 * 1024) = *reinterpret_cast<const bf16x8*>(Qr + d0 * 16); }
  const short* Kn = T.KN + rowbase * 1024 + h * 128; const short* Vh = T.V + rowbase * 1024 + h * 128; const short* Kr = T.KR + rowbase * 64;
  const int sr = tid >> 4, sc = (tid & 15) * 8, vst0 = v_st(sr, sc), vst1 = v_st(32 + sr, sc);
  const int krr = tid >> 3, krc = (tid & 7) * 8;
  const int vb0 = (int)(uintptr_t)V_lds + v_rd_base(lane);
  struct { bf16x8 vs0, vs1, ks0, ks1, kr; } sr_[SDEPTH];
#define LD8(p) (*reinterpret_cast<const bf16x8*>(p))
#define SLOAD(i, k0) do { sr_[i].vs0 = LD8(&Vh[(long)((k0) + sr) * 1024 + sc]); sr_[i].vs1 = LD8(&Vh[(long)((k0) + 32 + sr) * 1024 + sc]); \
    sr_[i].ks0 = LD8(&Kn[(long)((k0) + sr) * 1024 + sc]); sr_[i].ks1 = LD8(&Kn[(long)((k0) + 32 + sr) * 1024 + sc]); sr_[i].kr = LD8(&Kr[(long)((k0) + krr) * 64 + krc]); } while (0)
#define SWRITE(bb, i) do { *(bf16x8*)(V_lds + (bb) * SHM_V + vst0) = sr_[i].vs0; *(bf16x8*)(V_lds + (bb) * SHM_V + vst1) = sr_[i].vs1; const int kc = sc * 2; \
    *(bf16x8*)(KN_lds + (bb) * SHM_KN + KSWZ(sr, kc)) = sr_[i].ks0; *(bf16x8*)(KN_lds + (bb) * SHM_KN + KSWZ(32 + sr, kc)) = sr_[i].ks1; \
    *(bf16x8*)(KR_lds + (bb) * SHM_KR + KRSWZ(krr, krc * 2)) = sr_[i].kr; } while (0)
#define SWAIT() do { if constexpr (SDEPTH == 2) asm volatile("s_waitcnt vmcnt(5)" ::: "memory"); else asm volatile("s_waitcnt vmcnt(0)" ::: "memory"); } while (0)
#define RESC(a) do { if (__any((a) < 1.f)) { if (hi == 0) al_l[r32] = (a); asm volatile("s_waitcnt lgkmcnt(0)" ::: "memory"); \
    for (int d = 0; d < 4; ++d) for (int r = 0; r < 16; ++r) o[d][r] *= al_l[crow(r, hi)]; } } while (0)
  f32x16 pA0, pA1, pB0, pB1; float mnA, mnB, alA, alB; bf16x8 pa0, pa1, pa2, pa3; constexpr int NT = SEQ / KVBLK;
  constexpr int SE = 0, SO = SDEPTH - 1;
  SLOAD(SE, 0); asm volatile("s_waitcnt vmcnt(0)" ::: "memory"); SWRITE(0, SE); __syncthreads();
  qkt(pA0, pA1, KN_lds, KR_lds, qr, qrl, r32, hi); partialSM(pA0, pA1, m_reg, mnA, alA);
  SLOAD(SO, KVBLK); if constexpr (SDEPTH == 2) { if (2 < NT) SLOAD(SE, 2 * KVBLK); }
  SWAIT(); SWRITE(1, SO); __syncthreads();
  for (int j = 1; j + 1 < NT; j += 2) {
    SBAR(); qkt(pB0, pB1, KN_lds + SHM_KN, KR_lds + SHM_KR, qr, qrl, r32, hi);
    finishSM(pA0, pA1, alA, l_reg, pa0, pa1, pa2, pa3); SBAR();
    SLOAD(SO, (j + SDEPTH) * KVBLK); SBAR();
    pv_d0(o, vb0, pa0, pa1, pa2, pa3); partialSM(pB0, pB1, m_reg, mnB, alB);
    __syncthreads(); SWAIT(); SWRITE(0, SE);
    RESC(alB); __syncthreads();
    SBAR(); qkt(pA0, pA1, KN_lds, KR_lds, qr, qrl, r32, hi);
    finishSM(pB0, pB1, alB, l_reg, pa0, pa1, pa2, pa3); SBAR();
    if (SDEPTH == 1 || j + 3 < NT) SLOAD(SE, (j + 1 + SDEPTH) * KVBLK); SBAR();
    pv_d0(o, vb0 + SHM_V, pa0, pa1, pa2, pa3); partialSM(pA0, pA1, m_reg, mnA, alA);
    __syncthreads(); SWAIT(); SWRITE(1, SO);
    RESC(alA); __syncthreads();
  }
  SBAR(); qkt(pB0, pB1, KN_lds + SHM_KN, KR_lds + SHM_KR, qr, qrl, r32, hi);
  finishSM(pA0, pA1, alA, l_reg, pa0, pa1, pa2, pa3); SBAR();
  pv_d0(o, vb0, pa0, pa1, pa2, pa3); partialSM(pB0, pB1, m_reg, mnB, alB);
  __syncthreads(); RESC(alB);
  finishSM(pB0, pB1, alB, l_reg, pa0, pa1, pa2, pa3); SBAR();
  pv_d0(o, vb0 + SHM_V, pa0, pa1, pa2, pa3);
  if (hi == 0) li_l[r32] = l_reg; asm volatile("s_waitcnt lgkmcnt(0)" ::: "memory");
  float rli[16];
#pragma unroll
  for (int r = 0; r < 16; ++r) rli[r] = __builtin_amdgcn_rcpf(li_l[crow(r, hi)]);
  __syncthreads();
  { unsigned short* stg = (unsigned short*)(lds + wid * 8192);
#pragma unroll
    for (int r = 0; r < 16; ++r) { const int orow = crow(r, hi);
#pragma unroll
      for (int d0 = 0; d0 < 4; ++d0) stg[orow * 128 + d0 * 32 + r32] = f2bf_rne(o[d0][r] * rli[r]); }
    asm volatile("s_waitcnt lgkmcnt(0)" ::: "memory");
    unsigned short* Ow = T.O + (rowbase + qb * 256 + wid * QBLK) * 2048 + h * 128;
#pragma unroll
    for (int i = 0; i < 8; ++i) { const int row = i * 4 + (lane >> 4), ch = lane & 15; const u32x4 v = *(const u32x4*)(stg + row * 128 + ch * 8); *(u32x4*)(Ow + (long)row * 2048 + ch * 8) = v; } }
  __syncthreads();
#undef LD8
#undef SLOAD
#undef SWRITE
#undef SWAIT
#undef RESC
}
#undef KSWZ
#undef KRSWZ
#undef SBAR
}
namespace hg {
typedef short bf16x8 __attribute__((ext_vector_type(8)));
typedef float f32x4 __attribute__((ext_vector_type(4)));
typedef unsigned u32x4 __attribute__((ext_vector_type(4)));
typedef unsigned u32x2 __attribute__((ext_vector_type(2)));
constexpr int SQ = 272, ST = 144;
constexpr int OFF_QD = 0, OFF_KD = 64 * SQ, OFF_KDT = 2 * 64 * SQ, OFF_VT = OFF_KDT + 128 * ST, OFF_AM = OFF_VT + 128 * ST, OFF_TOT = OFF_AM + 64 * ST, OFF_DEC = OFF_TOT + 2 * 4 * 128 * 4, LDS_BYTES = OFF_DEC + 512;
typedef float f32x2_t __attribute__((ext_vector_type(2))); typedef __bf16 bf16x2_t __attribute__((ext_vector_type(2)));
__device__ __forceinline__ unsigned pkbf(float lo, float hi) { f32x2_t v = {lo, hi}; bf16x2_t bb = __builtin_convertvector(v, bf16x2_t); return __builtin_bit_cast(unsigned, bb); }
__device__ __forceinline__ float b2f(unsigned short h) { return __builtin_bit_cast(float, (unsigned)h << 16); }
__device__ __forceinline__ void hgrn_chain(int b, int h, int dir, const unsigned short* HQ, const unsigned short* FX, const unsigned short* HI, unsigned short* OD, const float* lbl, char* lds) {
  constexpr int SEQ = 4096, NC = SEQ / 64;
  const int tid = threadIdx.x, lane = tid & 63, w = __builtin_amdgcn_readfirstlane(tid >> 6), d = tid & 127, g = tid >> 7, l15 = lane & 15, lg = lane >> 4;
  char* QD = lds + OFF_QD; char* KD = lds + OFF_KD; char* KDT = lds + OFF_KDT; char* VT = lds + OFF_VT; char* AM = lds + OFF_AM; float* TOT = (float*)(lds + OFF_TOT); float* DEC = (float*)(lds + OFF_DEC);
  float lb; { const float a0 = lbl[h * 128 + d], a1 = lbl[1024 + h * 128 + d]; lb = 1.0f / (1.0f + __expf(a1 - a0)); }
  const size_t cb = (size_t)h * 128;
  const long rb = (long)b * SEQ;
#define ROWOF(t) ((size_t)(rb + (dir ? (SEQ - 1 - (t)) : (t))))
  unsigned short xr[16], qx[16]; u32x4 vreg[2];
  float cs[16], kk[16], qq[16];
  f32x4 S[8];
#pragma unroll
  for (int T = 0; T < 8; ++T) S[T] = (f32x4){0.f, 0.f, 0.f, 0.f};
#define LOADS(c) do { _Pragma("unroll") for (int i = 0; i < 16; ++i) { const size_t ro = ROWOF(64 * (c) + 16 * g + i) * 1024 + cb + d; xr[i] = FX[ro]; qx[i] = HQ[ro]; } \
    _Pragma("unroll") for (int jj = 0; jj < 2; ++jj) { const int idx = tid + 512 * jj, ec = idx >> 6, s = idx & 63; vreg[jj] = *(const u32x4*)(HI + ROWOF(64 * (c) + s) * 1024 + cb + 8 * ec); } } while (0)
#define PRE(c) do { float cl = 0.f; _Pragma("unroll") for (int i = 0; i < 16; ++i) { const float x = b2f(xr[i]); const float sg = __builtin_amdgcn_rcpf(1.0f + __builtin_amdgcn_exp2f(-1.4426950408889634f * x)); \
      const float f = lb + (1.0f - lb) * sg; cl += __builtin_amdgcn_logf(f); cs[i] = cl; kk[i] = 1.0f - f; qq[i] = b2f(qx[i]); } \
    TOT[(((c) & 1) * 4 + g) * 128 + d] = cl; } while (0)
  LOADS(0); PRE(0);
  __syncthreads();
  for (int c = 0; c < NC; ++c) {
    { const float* tp = TOT + (c & 1) * 512 + d; const float t0 = tp[0], t1 = tp[128], t2 = tp[256], t3 = tp[384];
      const float off = (g > 0 ? t0 : 0.f) + (g > 1 ? t1 : 0.f) + (g > 2 ? t2 : 0.f);
      if (g == 0) DEC[d] = __builtin_amdgcn_exp2f((t0 + t1) + (t2 + t3));
      float kd[16];
#pragma unroll
      for (int i = 0; i < 16; ++i) { const float bb = off + cs[i]; const float e1 = __builtin_amdgcn_exp2f(bb), e2 = __builtin_amdgcn_exp2f(-bb);
        const float qd = qq[i] * e1; kd[i] = kk[i] * e2;
        *(unsigned short*)(QD + (16 * g + i) * SQ + d * 2) = (unsigned short)(pkbf(qd, 0.f) & 0xffffu); }
      u32x4 k0, k1;
      k0.x = pkbf(kd[0], kd[1]); k0.y = pkbf(kd[2], kd[3]); k0.z = pkbf(kd[4], kd[5]); k0.w = pkbf(kd[6], kd[7]);
      k1.x = pkbf(kd[8], kd[9]); k1.y = pkbf(kd[10], kd[11]); k1.z = pkbf(kd[12], kd[13]); k1.w = pkbf(kd[14], kd[15]);
      *(u32x4*)(KDT + d * ST + 32 * g) = k0; *(u32x4*)(KDT + d * ST + 32 * g + 16) = k1;
#pragma unroll
      for (int i = 0; i < 8; ++i) { const unsigned wv = i < 4 ? k0[i] : k1[i - 4];
        *(unsigned short*)(KD + (16 * g + 2 * i) * SQ + d * 2) = (unsigned short)(wv & 0xffffu); *(unsigned short*)(KD + (16 * g + 2 * i + 1) * SQ + d * 2) = (unsigned short)(wv >> 16); }
#pragma unroll
      for (int jj = 0; jj < 2; ++jj) { const int idx = tid + 512 * jj, ec = idx >> 6, s = idx & 63;
#pragma unroll
        for (int j = 0; j < 4; ++j) { const unsigned wv = vreg[jj][j];
          *(unsigned short*)(VT + (8 * ec + 2 * j) * ST + s * 2) = (unsigned short)(wv & 0xffffu); *(unsigned short*)(VT + (8 * ec + 2 * j + 1) * ST + s * 2) = (unsigned short)(wv >> 16); } } }
    if (c + 1 < NC) LOADS(c + 1);
    __syncthreads();
    { const int ttile = w >> 1;
#pragma unroll
      for (int ss = 0; ss < 2; ++ss) { const int stile = 2 * (w & 1) + ss; f32x4 acc = {0.f, 0.f, 0.f, 0.f};
        if (stile <= ttile) {
#pragma unroll
          for (int ks = 0; ks < 4; ++ks) { const bf16x8 a = *(const bf16x8*)(KD + (16 * stile + l15) * SQ + (32 * ks + 8 * lg) * 2); const bf16x8 bq = *(const bf16x8*)(QD + (16 * ttile + l15) * SQ + (32 * ks + 8 * lg) * 2);
            acc = __builtin_amdgcn_mfma_f32_16x16x32_bf16(a, bq, acc, 0, 0, 0); } }
        const int t = 16 * ttile + l15, s0 = 16 * stile + 4 * lg;
#pragma unroll
        for (int r = 0; r < 4; ++r) if (s0 + r > t) acc[r] = 0.f;
        u32x2 pw; pw.x = pkbf(acc[0], acc[1]); pw.y = pkbf(acc[2], acc[3]); *(u32x2*)(AM + t * ST + s0 * 2) = pw; } }
    __syncthreads();
    { f32x4 o[4]; bf16x8 vb[2];
#pragma unroll
      for (int tt = 0; tt < 4; ++tt) o[tt] = (f32x4){0.f, 0.f, 0.f, 0.f};
#pragma unroll
      for (int ks = 0; ks < 2; ++ks) { vb[ks] = *(const bf16x8*)(VT + (16 * w + l15) * ST + (32 * ks + 8 * lg) * 2);
#pragma unroll
        for (int tt = 0; tt < 4; ++tt) { if (ks == 1 && tt < 2) continue; const bf16x8 a = *(const bf16x8*)(AM + (16 * tt + l15) * ST + (32 * ks + 8 * lg) * 2); o[tt] = __builtin_amdgcn_mfma_f32_16x16x32_bf16(a, vb[ks], o[tt], 0, 0, 0); } }
#pragma unroll
      for (int ks = 0; ks < 4; ++ks) { u32x4 sw; sw.x = pkbf(S[2 * ks][0], S[2 * ks][1]); sw.y = pkbf(S[2 * ks][2], S[2 * ks][3]); sw.z = pkbf(S[2 * ks + 1][0], S[2 * ks + 1][1]); sw.w = pkbf(S[2 * ks + 1][2], S[2 * ks + 1][3]);
        const bf16x8 sb = __builtin_bit_cast(bf16x8, sw);
#pragma unroll
        for (int tt = 0; tt < 4; ++tt) { const u32x2 alo = *(const u32x2*)(QD + (16 * tt + l15) * SQ + (32 * ks + 4 * lg) * 2), ahi = *(const u32x2*)(QD + (16 * tt + l15) * SQ + (32 * ks + 16 + 4 * lg) * 2);
          const u32x4 aw = {alo.x, alo.y, ahi.x, ahi.y}; o[tt] = __builtin_amdgcn_mfma_f32_16x16x32_bf16(__builtin_bit_cast(bf16x8, aw), sb, o[tt], 0, 0, 0); } }
#pragma unroll
      for (int tt = 0; tt < 4; ++tt)
#pragma unroll
        for (int r = 0; r < 4; ++r) OD[ROWOF(64 * c + 16 * tt + 4 * lg + r) * 1024 + cb + 16 * w + l15] = (unsigned short)(pkbf(o[tt][r], 0.f) & 0xffffu);
#pragma unroll
      for (int T = 0; T < 8; ++T) {
#pragma unroll
        for (int ks = 0; ks < 2; ++ks) { const bf16x8 a = *(const bf16x8*)(KDT + (16 * T + l15) * ST + (32 * ks + 8 * lg) * 2); S[T] = __builtin_amdgcn_mfma_f32_16x16x32_bf16(a, vb[ks], S[T], 0, 0, 0); }
        const f32x4 dv = *(const f32x4*)(DEC + 16 * T + 4 * lg); S[T] = S[T] * dv; } }
    if (c + 1 < NC) PRE(c + 1);
    __syncthreads();
  }
#undef ROWOF
#undef LOADS
#undef PRE
}
}
constexpr int NWAVES = 8;
#ifndef MK_N_LAUNCHES
#define MK_N_LAUNCHES 1
#endif
constexpr int NPH = 11;
constexpr int N_LAUNCHES = MK_N_LAUNCHES;
static_assert(N_LAUNCHES == 1 || N_LAUNCHES == NPH, "MK_N_LAUNCHES is 1 or NPH");

constexpr int NB = 4, SEQ = 4096, DM = 2048, M = NB * SEQ, FFD = 8192, NIN = 6144  , NIN_SRC = 5952, NMOD = 6 * DM;
constexpr size_t MiB = 1u << 20;
constexpr size_t WS_CTL = 0, CTL_ZERO_BYTES = 64 * 1024;
constexpr size_t WS_WIN = 1 * MiB, WS_QR = 1 * MiB  , WS_WUQ = 25 * MiB, WS_WUKV = 27 * MiB, WS_WOUT = 28 * MiB, WS_WUP = 36 * MiB, WS_WDN = 68 * MiB;
constexpr size_t WS_MOD = 100 * MiB, WS_CS = 101 * MiB, WS_QSS = 105 * MiB, WS_KVSS = 105 * MiB + 512 * 1024, WS_RSS = 106 * MiB, WS_KR = 108 * MiB;
constexpr size_t WS_XN = 112 * MiB, WS_OF = 112 * MiB, WS_OB = 144 * MiB, WS_Y = 112 * MiB;
constexpr size_t WS_HQ = 176 * MiB, WS_FF = 208 * MiB, WS_FB = 240 * MiB, WS_HI = 272 * MiB, WS_HG = 304 * MiB, WS_QN = 336 * MiB, WS_KN = 368 * MiB, WS_V = 400 * MiB;
constexpr size_t WS_QL = 432 * MiB, WS_KVL = 448 * MiB, WS_MIXIN = 448 * MiB, WS_MIX = 176 * MiB, WS_H = 176 * MiB, WS_END = 512 * MiB;
constexpr int CW_BAR = 4096;
constexpr int RING_OFF = 0, RING_BYTES = 131072, LDSCTL_OFF = RING_BYTES, MISC_OFF = LDSCTL_OFF + 320, LDS_BYTES = 147456;
static_assert(att::LDS_BYTES <= RING_BYTES && hg::LDS_BYTES <= RING_BYTES, "phase scratch inside the ring");

#define GAS __attribute__((address_space(1)))
#define LAS __attribute__((address_space(3)))
typedef unsigned short bf16;
typedef unsigned v4u __attribute__((ext_vector_type(4)));
typedef float f32x4 __attribute__((ext_vector_type(4)));
typedef short bf16x8 __attribute__((ext_vector_type(8)));
typedef GAS unsigned gu32;
typedef GAS unsigned long long gu64;
#define RLX_AGENT __ATOMIC_RELAXED, __HIP_MEMORY_SCOPE_AGENT
#define LDS_WAIT() asm volatile("s_waitcnt lgkmcnt(0)" ::: "memory")
#define VM_WAIT() asm volatile("s_waitcnt vmcnt(0)" ::: "memory")
__device__ __forceinline__ unsigned long long rt() { return __builtin_amdgcn_s_memrealtime(); }
__device__ __forceinline__ unsigned f2bf(float f) { unsigned u = __builtin_bit_cast(unsigned, f); return (u + 0x7fffu + ((u >> 16) & 1u)) >> 16; }
__device__ __forceinline__ unsigned pk2(float lo, float hi) { return f2bf(lo) | (f2bf(hi) << 16); }
#define XB_TMO      128
#define XB_XCNT(j)  (256  + 64 * (j))
#define XB_XSUB(j)  (1280 + 64 * (j))
#define XB_XGEN(j)  (2304 + 64 * (j))
#define XB_TOP      3328
#define XB_TOPGEN   3392
#define XCD_BAR_WORDS 3456
#define XB_SPIN_CAP (1u << 18)

__device__ __forceinline__ unsigned xb_ld(unsigned* p)              { return __hip_atomic_load(p, __ATOMIC_RELAXED, __HIP_MEMORY_SCOPE_AGENT); }
__device__ __forceinline__ unsigned xb_add(unsigned* p, unsigned v) { return __hip_atomic_fetch_add(p, v, __ATOMIC_RELAXED, __HIP_MEMORY_SCOPE_AGENT); }
__device__ __forceinline__ unsigned xb_xcc_id() { return (unsigned)__builtin_amdgcn_s_getreg((3 << 11) | 20) & 0xFu; }
#define XB_SPIN(cond, bar) do { unsigned _sp = 0; while (cond) { __builtin_amdgcn_s_sleep(1); \
    if ((++_sp & 255u) == 0u) { if (xb_ld(&(bar)[XB_TMO])) break; if (_sp > XB_SPIN_CAP) { atomicAdd(&(bar)[XB_TMO], 1u); break; } } } } while (0)

struct XcdBarrier {
    unsigned* bar; unsigned x;
    volatile LAS unsigned* st;
};

__device__ __forceinline__ XcdBarrier xcd_barrier_post(unsigned* bar, volatile LAS unsigned* st) {
    XcdBarrier b; b.bar = bar; b.x = xb_xcc_id(); b.st = st;
    if (threadIdx.x == 0) (void)xb_add(&bar[XB_XCNT(b.x)], 1u);
    return b;
}
__device__ __forceinline__ void xcd_barrier_complete(unsigned* bar, unsigned x, unsigned& nloc, unsigned& nx) {
    const unsigned G = gridDim.x * gridDim.y * gridDim.z;
    unsigned sum, cnt, mine, sp = 0u;
    for (;;) {
        sum = 0u; cnt = 0u; mine = 0u;
#pragma unroll
        for (unsigned j = 0; j < 16; ++j) { const unsigned c = xb_ld(&bar[XB_XCNT(j)]); sum += c; cnt += (c > 0u) ? 1u : 0u; mine = (j == x) ? c : mine; }
        if (sum == G) break;
        __builtin_amdgcn_s_sleep(1);
        if ((++sp & 255u) == 0u) { if (xb_ld(&bar[XB_TMO])) break; if (sp > XB_SPIN_CAP) { atomicAdd(&bar[XB_TMO], 1u); break; } }
    }
    nloc = mine > 0u ? mine : 1u; nx = cnt > 0u ? cnt : 1u;
}

__device__ __forceinline__ void xcd_barrier(const XcdBarrier& b) {
    asm volatile("s_waitcnt vmcnt(0)" ::: "memory");
    __syncthreads();
    if (threadIdx.x == 0) {
        unsigned* bar = b.bar;
        __builtin_amdgcn_s_waitcnt(0);
        unsigned nloc = b.st[0], nx = b.st[1];
        if (nloc == 0u) { xcd_barrier_complete(bar, b.x, nloc, nx); b.st[0] = nloc; b.st[1] = nx; }
        const unsigned old = xb_add(&bar[XB_XSUB(b.x)], 1u);
        const unsigned gen = old / nloc;
        if (old + 1u == (gen + 1u) * nloc) {
            __builtin_amdgcn_fence(__ATOMIC_RELEASE, "agent");
            asm volatile("s_waitcnt vmcnt(0)" ::: "memory");
            const unsigned og = xb_add(&bar[XB_TOP], 1u);
            const unsigned tg = og / nx;
            if (og + 1u == (tg + 1u) * nx) xb_add(&bar[XB_TOPGEN], 1u);
            else XB_SPIN(xb_ld(&bar[XB_TOPGEN]) == tg, bar);
            __builtin_amdgcn_fence(__ATOMIC_ACQUIRE, "agent");
            xb_add(&bar[XB_XGEN(b.x)], 1u);
            asm volatile("s_waitcnt vmcnt(0)" ::: "memory");
        } else {
            XB_SPIN(xb_ld(&bar[XB_XGEN(b.x)]) == gen, bar);
            __builtin_amdgcn_fence(__ATOMIC_ACQUIRE, "agent");
            asm volatile("s_waitcnt vmcnt(0)" ::: "memory");
        }
    }
    __syncthreads();
}

__device__ __forceinline__ float wave_sum(float v) {
#pragma unroll
    for (int o = 1; o < 64; o <<= 1) v += __shfl_xor(v, o);
    return v;
}
__device__ __forceinline__ float bf2f(unsigned short h) { return __builtin_bit_cast(float, (unsigned)h << 16); }
__device__ __forceinline__ float bflo(unsigned w) { return __builtin_bit_cast(float, w << 16); }
__device__ __forceinline__ float bfhi(unsigned w) { return __builtin_bit_cast(float, w & 0xffff0000u); }
__device__ __forceinline__ float sigmoidf_(float x) { return 1.0f / (1.0f + __expf(-x)); }

struct Args { const float* in[20]; float* out; unsigned char* ws; int ph_lo, ph_hi; };
struct Ctx { int tid, lane, wave, vcu, G; LAS unsigned char* lds; };

template <int MODE> __device__ __forceinline__ int src_col(int n) {
    if (MODE == 1) { if (n < 768) return n; if (n < 5888) return n + 64; if (n < 5952) { const int j = n - 5888; return 768 + (j & 1) * 32 + (j >> 1); } return -1; }
    if (MODE == 2) { if (n < 1024) return (n >> 7) * 192 + (n & 127); const int r = n - 1024, h = r >> 6, j = r & 63; return h * 192 + 128 + (j & 1) * 32 + (j >> 1); }
    return n;
}
template <int MODE> __device__ __forceinline__ void transpose_item(const float* W, int K, int Nsrc, int Ndst, const float* gain, bf16* WT, LAS float* scr, int item, int lane) {
    const int nblk = Ndst / 32, kb = item / nblk, nb = item % nblk, k0 = 64 * kb, n0 = 32 * nb;
    const int c = src_col<MODE>(n0 + (lane & 31));
#pragma unroll 8
    for (int i = 0; i < 32; ++i) { const int kk = 2 * i + (lane >> 5); float v = 0.f; if (c >= 0) v = W[(size_t)(k0 + kk) * Nsrc + c]; if (gain) v *= gain[k0 + kk]; scr[kk * 33 + (lane & 31)] = v; }
    LDS_WAIT(); asm volatile("" ::: "memory");
    const int cc = lane & 7;
#pragma unroll
    for (int j = 0; j < 4; ++j) { const int n = (lane >> 3) + 8 * j; const LAS float* s = scr + (8 * cc) * 33 + n;
        v4u o; o.x = pk2(s[0 * 33], s[1 * 33]); o.y = pk2(s[2 * 33], s[3 * 33]); o.z = pk2(s[4 * 33], s[5 * 33]); o.w = pk2(s[6 * 33], s[7 * 33]);
        *(GAS v4u*)(WT + (size_t)(n0 + n) * K + k0 + 8 * cc) = o; }
    LDS_WAIT(); asm volatile("" ::: "memory");
}

__global__ void __launch_bounds__(NWAVES * 64, 2) mk_fwd(Args args) {
    extern __shared__ __attribute__((aligned(16))) unsigned char lds[];
    Ctx C; C.lds = (LAS unsigned char*)lds; C.tid = threadIdx.x; C.lane = C.tid & 63; C.wave = __builtin_amdgcn_readfirstlane(C.tid >> 6);
    C.G = gridDim.x; { const int bx = blockIdx.x; C.vcu = (C.G % 8 == 0) ? (bx % 8) * (C.G / 8) + bx / 8 : bx; }
    volatile LAS unsigned* MISC = (volatile LAS unsigned*)(C.lds + MISC_OFF);
    unsigned char* ws = args.ws;
    gu32* ctl = (gu32*)(ws + WS_CTL);
    for (int u = C.tid; u < (LDS_BYTES - LDSCTL_OFF) / 4; u += NWAVES * 64) ((LAS unsigned*)(C.lds + LDSCTL_OFF))[u] = 0u;
    __syncthreads();
    XcdBarrier bar; bar.bar = (unsigned*)(ctl + CW_BAR); bar.x = 0; bar.st = nullptr;
    if (N_LAUNCHES == 1) bar = xcd_barrier_post((unsigned*)(ctl + CW_BAR), MISC + 8);
#define GRID_BAR() do { if (N_LAUNCHES == 1) xcd_barrier(bar); } while (0)
    const int lo = args.ph_lo, hi = args.ph_hi;
#ifndef PH_MASK
#define PH_MASK 0xfff
#endif
#define IN(k) (((PH_MASK >> (k)) & 1) && lo <= (k) && (k) < hi)
#define BOTH(k) (IN(k) && IN((k) + 1))
    const int gw = C.vcu * NWAVES + C.wave, NGW = C.G * NWAVES;
    const float* x = args.in[0]; const float* cin = args.in[1]; const int* positions = (const int*)args.in[2];
    const float* w_mod = args.in[3]; const float* b_mod = args.in[4]; const float* pre_mix_g = args.in[5]; const float* post_mix_g = args.in[6];
    const float* pre_mlp_g = args.in[7]; const float* post_mlp_g = args.in[8]; const float* w_in = args.in[9]; const float* q_norm_g = args.in[10]; const float* kv_norm_g = args.in[11];
    const float* w_uq = args.in[12]; const float* w_ukv = args.in[13]; const float* hgrn_norm_g = args.in[14]; const float* lbl_f = args.in[15]; const float* lbl_b = args.in[16];
    const float* w_out = args.in[17]; const float* w_up = args.in[18]; const float* w_down = args.in[19];
    float* out = args.out;
    bf16* Win_t = (bf16*)(ws + WS_WIN); bf16* Wuq_t = (bf16*)(ws + WS_WUQ); bf16* Wukv_t = (bf16*)(ws + WS_WUKV); bf16* Wout_t = (bf16*)(ws + WS_WOUT); bf16* Wup_t = (bf16*)(ws + WS_WUP); bf16* Wdn_t = (bf16*)(ws + WS_WDN);
    float* mod = (float*)(ws + WS_MOD); float* cs = (float*)(ws + WS_CS); float* qss = (float*)(ws + WS_QSS); float* kvss = (float*)(ws + WS_KVSS); float* rss = (float*)(ws + WS_RSS);
    bf16* KR = (bf16*)(ws + WS_KR); bf16* XN = (bf16*)(ws + WS_XN); bf16* OF = (bf16*)(ws + WS_OF); bf16* OB = (bf16*)(ws + WS_OB); bf16* Y = (bf16*)(ws + WS_Y);
    bf16* HQ = (bf16*)(ws + WS_HQ); bf16* FF = (bf16*)(ws + WS_FF); bf16* FB = (bf16*)(ws + WS_FB); bf16* HI = (bf16*)(ws + WS_HI); bf16* HG = (bf16*)(ws + WS_HG);
    bf16* QN = (bf16*)(ws + WS_QN); bf16* QR = (bf16*)(ws + WS_QR); bf16* KN = (bf16*)(ws + WS_KN); bf16* V = (bf16*)(ws + WS_V); bf16* QL = (bf16*)(ws + WS_QL); bf16* KVL = (bf16*)(ws + WS_KVL);
    bf16* MIXIN = (bf16*)(ws + WS_MIXIN); bf16* MIX = (bf16*)(ws + WS_MIX); bf16* H = (bf16*)(ws + WS_H);

    if (IN(0)) {
        for (int u = C.vcu; u < NMOD / 64; u += C.G) {
            LAS float* condT = (LAS float*)(C.lds);
            LAS float* part = (LAS float*)(C.lds + 32768);
            for (int k = C.tid; k < DM; k += NWAVES * 64) {
#pragma unroll
                for (int b = 0; b < NB; ++b) { const float c = cin[b * DM + k]; condT[k * 4 + b] = c * sigmoidf_(c); } }
            __syncthreads();
            const int col = 64 * u + C.lane; f32x4 acc = {0.f, 0.f, 0.f, 0.f};
            const float* wp = w_mod + (size_t)(C.wave * 256) * NMOD + col;
#pragma unroll 8
            for (int k = 0; k < 256; ++k) { const float w = wp[(size_t)k * NMOD]; const f32x4 cv = *(const LAS f32x4*)(condT + (C.wave * 256 + k) * 4); acc += cv * w; }
#pragma unroll
            for (int b = 0; b < NB; ++b) part[(C.wave * 4 + b) * 64 + C.lane] = acc[b];
            __syncthreads();
            if (C.tid < 256) { const int b = C.tid >> 6, l = C.tid & 63; float s = b_mod[64 * u + l];
#pragma unroll
                for (int w = 0; w < 8; ++w) s += part[(w * 4 + b) * 64 + l];
                mod[b * NMOD + 64 * u + l] = s; }
            __syncthreads();
        }
        for (int idx = gw * 64 + C.lane; idx < M * 32; idx += NGW * 64) { const int row = idx >> 5, i = idx & 31;
            const float invf = powf(10000.0f, -(float)i * (1.0f / 32.0f)); const float ang = (float)positions[row] * invf;
            pg8::f32x2 v; v.x = cosf(ang); v.y = sinf(ang); *(pg8::f32x2*)(cs + (size_t)idx * 2) = v; }
        LAS float* scr = (LAS float*)(C.lds + RING_OFF + C.wave * 16384);
        constexpr int I_IN = (DM / 64) * (NIN / 32), I_UQ = (512 / 64) * (1536 / 32), I_UKV = (256 / 64) * (2048 / 32), I_OUT = (DM / 64) * (DM / 32), I_UP = (DM / 64) * (FFD / 32), I_DN = (FFD / 64) * (DM / 32);
        constexpr int NITEMS = I_IN + I_UQ + I_UKV + I_OUT + I_UP + I_DN;
        for (int it = gw; it < NITEMS; it += NGW) {
            int r = it;
            if (r < I_IN) { transpose_item<1>(w_in, DM, NIN_SRC, NIN, nullptr, Win_t, scr, r, C.lane); continue; } r -= I_IN;
            if (r < I_UQ) { transpose_item<2>(w_uq, 512, 1536, 1536, q_norm_g, Wuq_t, scr, r, C.lane); continue; } r -= I_UQ;
            if (r < I_UKV) { transpose_item<0>(w_ukv, 256, 2048, 2048, kv_norm_g, Wukv_t, scr, r, C.lane); continue; } r -= I_UKV;
            if (r < I_OUT) { transpose_item<0>(w_out, DM, DM, DM, nullptr, Wout_t, scr, r, C.lane); continue; } r -= I_OUT;
            if (r < I_UP) { transpose_item<0>(w_up, DM, FFD, FFD, nullptr, Wup_t, scr, r, C.lane); continue; } r -= I_UP;
            transpose_item<0>(w_down, FFD, DM, DM, nullptr, Wdn_t, scr, r, C.lane);
        }
        if (BOTH(0)) GRID_BAR();
    }
    if (IN(1)) {
        for (int r = gw; r < M; r += NGW) { const int b = r / SEQ; const float* mb = mod + b * NMOD;
            const GAS f32x4* xr = (const GAS f32x4*)(x + (size_t)r * DM) + C.lane; f32x4 v[8]; float s = 0.f;
#pragma unroll
            for (int j = 0; j < 8; ++j) { v[j] = xr[64 * j]; s += (v[j].x * v[j].x + v[j].y * v[j].y) + (v[j].z * v[j].z + v[j].w * v[j].w); }
            const float rstd = 1.0f / sqrtf(wave_sum(s) * (1.0f / DM) + 1e-6f);
            GAS unsigned long long* o8 = (GAS unsigned long long*)(XN + (size_t)r * DM) + C.lane;
#pragma unroll
            for (int j = 0; j < 8; ++j) { const int c0 = 4 * C.lane + 256 * j; const f32x4 g = *(const f32x4*)(pre_mix_g + c0), sh = *(const f32x4*)(mb + c0), sc = *(const f32x4*)(mb + DM + c0);
                const f32x4 h = v[j] * rstd * g * (sc + 1.0f) + sh;
                o8[64 * j] = (unsigned long long)pk2(h.x, h.y) | ((unsigned long long)pk2(h.z, h.w) << 32); } }
        if (BOTH(1)) GRID_BAR();
    }
    if (IN(2)) {
        pg8::Gemm g{XN, Win_t, M, NIN, DM}; pg8::StaticOrder S; S.init(M, NIN, C.G, (int)blockIdx.x);
        pg8::EpiProj E{QL, KVL, HQ, FF, FB, HI, HG, KR, qss, kvss, cs};
        pg8::gemm_phase<pg8::EpiProj, pg8::StaticOrder, PG8_ALIGN, PG8_SP2>(C.lds + RING_OFF, g, S, E);
        if (BOTH(2)) GRID_BAR();
    }
    if (IN(3)) {
        { pg8::Gemm g{QL, Wuq_t, M, 1536, 512}; pg8::StaticOrder S; S.init(M, 1536, C.G, (int)blockIdx.x);
          pg8::EpiQ E{QN, QR, qss, cs};
          pg8::gemm_phase<pg8::EpiQ, pg8::StaticOrder, PG8_ALIGN, PG8_SP2>(C.lds + RING_OFF, g, S, E); }
        { pg8::Gemm g{KVL, Wukv_t, M, 2048, 256}; pg8::StaticOrder S; S.init(M, 2048, C.G, (int)blockIdx.x);
          pg8::EpiKV E{KN, V, kvss};
          pg8::gemm_phase<pg8::EpiKV, pg8::StaticOrder, PG8_ALIGN, PG8_SP2>(C.lds + RING_OFF, g, S, E); }
        if (BOTH(3)) GRID_BAR();
    }
    if (IN(4) || (((PH_MASK >> 11) & 1) && lo <= 4 && 4 < hi)) {
        if ((PH_MASK >> 4) & 1) { const att::Tens T{(const short*)QN, (const short*)QR, (const short*)KN, (const short*)KR, (const short*)V, (unsigned short*)MIXIN};
          const int per = (512 + C.G - 1) / C.G;
          for (int i = 0; i < per; ++i) { const int id = C.vcu * per + i; if (id >= 512) break; const int bh = id >> 4, qb = id & 15; att::attn_unit(bh >> 3, bh & 7, qb, T, (char*)lds + RING_OFF); } }
#if defined(HGRN_NAIVE)
        if (((PH_MASK >> 11) & 1) && C.wave == 0) {
            for (int task = C.vcu; task < 128; task += C.G) {
                const int ch = task >> 1, eb = task & 1, b = ch >> 4, h = (ch >> 1) & 7, dir = ch & 1;
                const float* lbl = dir ? lbl_b : lbl_f; const bf16* FX = dir ? FB : FF; bf16* OD = dir ? OB : OF;
                float lb0, lb1; { const float a0 = lbl[h * 128 + C.lane], a1 = lbl[1024 + h * 128 + C.lane]; lb0 = 1.0f / (1.0f + __expf(a1 - a0));
                                  const float c0 = lbl[h * 128 + 64 + C.lane], c1 = lbl[1024 + h * 128 + 64 + C.lane]; lb1 = 1.0f / (1.0f + __expf(c1 - c0)); }
                float S[128];
#pragma unroll
                for (int d = 0; d < 128; ++d) S[d] = 0.f;
                const int e = eb * 64 + C.lane;
                size_t ro = ((size_t)b * SEQ + (dir ? SEQ - 1 : 0)) * 1024 + h * 128; const long step = dir ? -1024 : 1024;
                unsigned short nx0 = FX[ro + C.lane], nx1 = FX[ro + 64 + C.lane], nq0 = HQ[ro + C.lane], nq1 = HQ[ro + 64 + C.lane], nv = HI[ro + e];
                for (int t = 0; t < SEQ; ++t) {
                    const unsigned short x0 = nx0, x1 = nx1, q0 = nq0, q1 = nq1, vv = nv; const size_t rc = ro;
                    if (t + 1 < SEQ) { ro += step; nx0 = FX[ro + C.lane]; nx1 = FX[ro + 64 + C.lane]; nq0 = HQ[ro + C.lane]; nq1 = HQ[ro + 64 + C.lane]; nv = HI[ro + e]; }
                    const float f0 = lb0 + (1.0f - lb0) * sigmoidf_(bf2f(x0)), f1 = lb1 + (1.0f - lb1) * sigmoidf_(bf2f(x1));
                    const float k0 = 1.0f - f0, k1 = 1.0f - f1, qf0 = bf2f(q0), qf1 = bf2f(q1), v = bf2f(vv);
                    float o = 0.f;
#pragma unroll
                    for (int d = 0; d < 128; ++d) {
                        const float fd = __builtin_bit_cast(float, __builtin_amdgcn_readlane(__builtin_bit_cast(int, d < 64 ? f0 : f1), d & 63));
                        const float kd = __builtin_bit_cast(float, __builtin_amdgcn_readlane(__builtin_bit_cast(int, d < 64 ? k0 : k1), d & 63));
                        const float qd = __builtin_bit_cast(float, __builtin_amdgcn_readlane(__builtin_bit_cast(int, d < 64 ? qf0 : qf1), d & 63));
                        S[d] = fd * S[d] + kd * v; o += qd * S[d]; }
                    OD[rc + e] = (bf16)f2bf(o);
                }
            }
        }
#else
        if (((PH_MASK >> 11) & 1) && (C.vcu & 3) == 0) {
            for (int ch = C.vcu >> 2; ch < 64; ch += (C.G + 3) / 4) { const int b = ch >> 4, h = (ch >> 1) & 7, dir = ch & 1;
                hg::hgrn_chain(b, h, dir, (const unsigned short*)HQ, (const unsigned short*)(dir ? FB : FF), (const unsigned short*)HI, (unsigned short*)(dir ? OB : OF), dir ? lbl_b : lbl_f, (char*)lds + RING_OFF); }
        }
#endif
        if (BOTH(4)) GRID_BAR();
    }
    if (IN(5)) {
        for (int r = gw; r < M; r += NGW) { const size_t o16 = (size_t)r * 1024 + 16 * C.lane;
            const v4u a0 = *(const GAS v4u*)(OF + o16), a1 = *(const GAS v4u*)(OF + o16 + 8), b0 = *(const GAS v4u*)(OB + o16), b1 = *(const GAS v4u*)(OB + o16 + 8);
            const v4u g0 = *(const GAS v4u*)(HG + o16), g1 = *(const GAS v4u*)(HG + o16 + 8);
            float sv[16]; float ss = 0.f;
#pragma unroll
            for (int i = 0; i < 4; ++i) { sv[2 * i] = bflo(a0[i]) + bflo(b0[i]); sv[2 * i + 1] = bfhi(a0[i]) + bfhi(b0[i]); sv[8 + 2 * i] = bflo(a1[i]) + bflo(b1[i]); sv[8 + 2 * i + 1] = bfhi(a1[i]) + bfhi(b1[i]); }
#pragma unroll
            for (int i = 0; i < 16; ++i) ss += sv[i] * sv[i];
            ss += __shfl_xor(ss, 1); ss += __shfl_xor(ss, 2); ss += __shfl_xor(ss, 4);
            const float rstd = 1.0f / sqrtf(ss * (1.0f / 128.0f) + 1e-6f);
            const float* gp = hgrn_norm_g + ((16 * C.lane) & 127); float ov[16];
#pragma unroll
            for (int i = 0; i < 4; ++i) { const float h0 = bflo(g0[i]), h1 = bfhi(g0[i]), h2 = bflo(g1[i]), h3 = bfhi(g1[i]);
                ov[2 * i] = sv[2 * i] * rstd * gp[2 * i] * (h0 * sigmoidf_(h0)); ov[2 * i + 1] = sv[2 * i + 1] * rstd * gp[2 * i + 1] * (h1 * sigmoidf_(h1));
                ov[8 + 2 * i] = sv[8 + 2 * i] * rstd * gp[8 + 2 * i] * (h2 * sigmoidf_(h2)); ov[8 + 2 * i + 1] = sv[8 + 2 * i + 1] * rstd * gp[8 + 2 * i + 1] * (h3 * sigmoidf_(h3)); }
            v4u w0, w1;
#pragma unroll
            for (int i = 0; i < 4; ++i) { w0[i] = pk2(ov[2 * i], ov[2 * i + 1]); w1[i] = pk2(ov[8 + 2 * i], ov[8 + 2 * i + 1]); }
            bf16* op = MIXIN + (size_t)r * 2048 + 1024 + 16 * C.lane; *(GAS v4u*)op = w0; *(GAS v4u*)(op + 8) = w1; }
        if (BOTH(5)) GRID_BAR();
    }
    if (IN(6)) {
        pg8::Gemm g{MIXIN, Wout_t, M, DM, DM}; pg8::StaticOrder S; S.init(M, DM, C.G, (int)blockIdx.x);
        pg8::EpiOut<0, true> E{MIX, DM, rss};
        pg8::gemm_phase<pg8::EpiOut<0, true>, pg8::StaticOrder, PG8_ALIGN, PG8_SP2>(C.lds + RING_OFF, g, S, E);
        if (BOTH(6)) GRID_BAR();
    }
    if (IN(7)) {
        for (int r = gw; r < M; r += NGW) { const int b = r / SEQ; const float* mb = mod + b * NMOD;
            const float sm = wave_sum(C.lane < 32 ? rss[(size_t)r * 32 + C.lane] : 0.f); const float rstd_m = 1.0f / sqrtf(sm * (1.0f / DM) + 1e-6f);
            const GAS f32x4* xr = (const GAS f32x4*)(x + (size_t)r * DM) + C.lane; const GAS unsigned long long* mr = (const GAS unsigned long long*)(MIX + (size_t)r * DM) + C.lane;
            GAS f32x4* orow = (GAS f32x4*)(out + (size_t)r * DM) + C.lane;
            f32x4 v[8]; float s = 0.f;
#pragma unroll
            for (int j = 0; j < 8; ++j) { const int c0 = 4 * C.lane + 256 * j; const unsigned long long mw = mr[64 * j]; const unsigned lo_ = (unsigned)mw, hi_ = (unsigned)(mw >> 32);
                const f32x4 mx = {bflo(lo_), bfhi(lo_), bflo(hi_), bfhi(hi_)}; const f32x4 g = *(const f32x4*)(post_mix_g + c0), ga = *(const f32x4*)(mb + 2 * DM + c0);
                v[j] = xr[64 * j] + ga * (mx * rstd_m * g); orow[64 * j] = v[j];
                s += (v[j].x * v[j].x + v[j].y * v[j].y) + (v[j].z * v[j].z + v[j].w * v[j].w); }
            const float rstd = 1.0f / sqrtf(wave_sum(s) * (1.0f / DM) + 1e-6f);
            GAS unsigned long long* o8 = (GAS unsigned long long*)(XN + (size_t)r * DM) + C.lane;
#pragma unroll
            for (int j = 0; j < 8; ++j) { const int c0 = 4 * C.lane + 256 * j; const f32x4 g = *(const f32x4*)(pre_mlp_g + c0), sh = *(const f32x4*)(mb + 3 * DM + c0), sc = *(const f32x4*)(mb + 4 * DM + c0);
                const f32x4 h = v[j] * rstd * g * (sc + 1.0f) + sh;
                o8[64 * j] = (unsigned long long)pk2(h.x, h.y) | ((unsigned long long)pk2(h.z, h.w) << 32); } }
        if (BOTH(7)) GRID_BAR();
    }
    if (IN(8)) {
        pg8::Gemm g{XN, Wup_t, M, FFD, DM}; pg8::StaticOrder S; S.init(M, FFD, C.G, (int)blockIdx.x);
        pg8::EpiOut<1, false> E{H, FFD, nullptr};
        pg8::gemm_phase<pg8::EpiOut<1, false>, pg8::StaticOrder, PG8_ALIGN, PG8_SP2>(C.lds + RING_OFF, g, S, E);
        if (BOTH(8)) GRID_BAR();
    }
    if (IN(9)) {
        pg8::Gemm g{H, Wdn_t, M, DM, FFD}; pg8::StaticOrder S; S.init(M, DM, C.G, (int)blockIdx.x);
        pg8::EpiOut<0, true> E{Y, DM, rss};
        pg8::gemm_phase<pg8::EpiOut<0, true>, pg8::StaticOrder, PG8_ALIGN, PG8_SP2>(C.lds + RING_OFF, g, S, E);
        if (BOTH(9)) GRID_BAR();
    }
    if (IN(10)) {
        for (int r = gw; r < M; r += NGW) { const int b = r / SEQ; const float* mb = mod + b * NMOD;
            const float sm = wave_sum(C.lane < 32 ? rss[(size_t)r * 32 + C.lane] : 0.f); const float rstd_y = 1.0f / sqrtf(sm * (1.0f / DM) + 1e-6f);
            const GAS unsigned long long* yr = (const GAS unsigned long long*)(Y + (size_t)r * DM) + C.lane; GAS f32x4* orow = (GAS f32x4*)(out + (size_t)r * DM) + C.lane;
#pragma unroll
            for (int j = 0; j < 8; ++j) { const int c0 = 4 * C.lane + 256 * j; const unsigned long long yw = yr[64 * j]; const unsigned lo_ = (unsigned)yw, hi_ = (unsigned)(yw >> 32);
                const f32x4 yx = {bflo(lo_), bfhi(lo_), bflo(hi_), bfhi(hi_)}; const f32x4 g = *(const f32x4*)(post_mlp_g + c0), gm = *(const f32x4*)(mb + 5 * DM + c0);
                orow[64 * j] = orow[64 * j] + gm * (yx * rstd_y * g); } }
    }
#undef IN
#undef BOTH
#undef GRID_BAR
}

extern "C" void kernel_launch(void* const* d_in, const int* in_sizes, int n_in, void* d_out, int out_size, void* d_ws, size_t ws_size, hipStream_t stream) {
    static int grid = 0;
    if (grid == 0) {
        if (n_in != 20 || in_sizes[0] != M * DM || out_size != M * DM || ws_size < WS_END) { fprintf(stderr, "kernel_launch: unexpected shapes: n_in %d in0 %d out %d ws %zu (need %zu)\n", n_in, n_in > 0 ? in_sizes[0] : -1, out_size, ws_size, (size_t)WS_END); grid = -1; return; }
        int dev = 0, cus = 0;
        if (hipGetDevice(&dev) != hipSuccess || hipDeviceGetAttribute(&cus, hipDeviceAttributeMultiprocessorCount, dev) != hipSuccess) { fprintf(stderr, "kernel_launch: device query failed\n"); grid = -1; return; }
        if (hipFuncSetAttribute((const void*)mk_fwd, hipFuncAttributeMaxDynamicSharedMemorySize, LDS_BYTES) != hipSuccess) { fprintf(stderr, "kernel_launch: hipFuncSetAttribute failed\n"); grid = -1; return; }
        int per_cu = 0;
        if (hipOccupancyMaxActiveBlocksPerMultiprocessor(&per_cu, (const void*)mk_fwd, NWAVES * 64, LDS_BYTES) != hipSuccess || per_cu < 1) fprintf(stderr, "kernel_launch: note: occupancy query reports %d workgroups per CU\n", per_cu);
        (void)hipGetLastError();
        grid = cus;
    }
    if (grid < 0) return;
    if (hipMemsetAsync((char*)d_ws + WS_CTL, 0, CTL_ZERO_BYTES, stream) != hipSuccess) { fprintf(stderr, "kernel_launch: memset failed\n"); return; }
    Args a{};
    for (int i = 0; i < 20; ++i) a.in[i] = (const float*)d_in[i];
    a.out = (float*)d_out; a.ws = (unsigned char*)d_ws;
    for (int li = 0; li < N_LAUNCHES; ++li) {
        a.ph_lo = (N_LAUNCHES == 1) ? 0 : li; a.ph_hi = (N_LAUNCHES == 1) ? NPH : li + 1;
        hipLaunchKernelGGL(mk_fwd, dim3(grid), dim3(NWAVES * 64), LDS_BYTES, stream, a);
        const hipError_t le = hipPeekAtLastError();
        if (le != hipSuccess) { fprintf(stderr, "kernel_launch: launch %d failed: %s\n", li, hipGetErrorName(le)); break; }
    }
}
```

```cpp
#include <hip/hip_runtime.h>
#include <hip/hip_bf16.h>
#include <cstdio>
#include <cstdint>
#include <cmath>
namespace pg8 {
#define PG8_LAS __attribute__((address_space(3)))
typedef unsigned short bf16_t;
typedef short bf16x8 __attribute__((ext_vector_type(8)));
typedef float f32x4 __attribute__((ext_vector_type(4)));
typedef unsigned u32x4 __attribute__((ext_vector_type(4)));
constexpr int BM = 256, BK = 64, HALF = 128, HTB = HALF * BK * 2  , STAGE_BYTES = 8 * HTB, NXCD = 8, WGM = 8;

__host__ __device__ __forceinline__ int lds_byte(int r, int c) { const int st = (r >> 4) * 2 + (c >> 5), rr = r & 15, cc = c & 31, ob = rr * 64 + cc * 2; return st * 1024 + (ob ^ (((ob >> 9) & 1) << 5)); }
__host__ __device__ __forceinline__ void stage_rc(int b, int& R, int& C) { const int st = b / 1024, sb = b % 1024, swz = sb ^ (((sb >> 9) & 1) << 5); R = (st >> 1) * 16 + swz / 64; C = (st & 1) * 32 + (swz % 64) / 2; }
__host__ __device__ __forceinline__ int perm32(int rho) { const int n = rho >> 4, i = rho & 15; return 8 * (i >> 2) + 4 * n + (i & 3); }

struct Unit { int pm, pn; };
struct Gemm { const bf16_t* A; const bf16_t* Bt; int M, N, K; };

struct StaticOrder {
    int nM, nN, nwg, G, c;
    __host__ __device__ void init(int M, int N, int G_, int c_) { nM = M / BM; nN = N / BM; nwg = nM * nN; G = G_; c = c_; }
    __host__ __device__ bool next(int i, Unit& u) const {
        const long L = (long)i * G + c; if (L >= nwg) return false;
        int wgid = (int)L; { const int q = nwg / NXCD, r = nwg % NXCD, xcd = wgid % NXCD, off = wgid / NXCD; wgid = (xcd < r ? xcd * (q + 1) : r * (q + 1) + (xcd - r) * q) + off; }
        const int nig = WGM * nN, gid = wgid / nig, fm = gid * WGM, gsz = (nM - fm) < WGM ? (nM - fm) : WGM;
        u.pm = fm + ((wgid % nig) % gsz); u.pn = (wgid % nig) / gsz; return true;
    }
    __device__ __forceinline__ void a_ready(const Unit&) const {}
    __device__ __forceinline__ void done(const Unit&) const {}
};

typedef float f32x2c_t __attribute__((ext_vector_type(2))); typedef __bf16 bf16x2c_t __attribute__((ext_vector_type(2)));
__device__ __forceinline__ unsigned cvt_pk_bf16(float lo, float hi) { f32x2c_t v = {lo, hi}; bf16x2c_t bb = __builtin_convertvector(v, bf16x2c_t); return __builtin_bit_cast(unsigned, bb); }
typedef float f32x2 __attribute__((ext_vector_type(2)));
__device__ __forceinline__ u32x4 pack8(const f32x4 a, const f32x4 b) { u32x4 w; w.x = cvt_pk_bf16(a[0], a[1]); w.y = cvt_pk_bf16(a[2], a[3]); w.z = cvt_pk_bf16(b[0], b[1]); w.w = cvt_pk_bf16(b[2], b[3]); return w; }
__device__ __forceinline__ void rope8(f32x4& a, f32x4& b, const float* csp) {
    const f32x4 c0 = *(const f32x4*)csp, c1 = *(const f32x4*)(csp + 4);
    f32x4 ra, rb;
    ra[0] = a[0] * c0[0] - a[1] * c0[1]; ra[1] = a[0] * c0[1] + a[1] * c0[0];
    ra[2] = a[2] * c0[2] - a[3] * c0[3]; ra[3] = a[2] * c0[3] + a[3] * c0[2];
    rb[0] = b[0] * c1[0] - b[1] * c1[1]; rb[1] = b[0] * c1[1] + b[1] * c1[0];
    rb[2] = b[2] * c1[2] - b[3] * c1[3]; rb[3] = b[2] * c1[3] + b[3] * c1[2];
    a = ra; b = rb;
}
__device__ __forceinline__ float sq4(const f32x4 x) { return (x[0] * x[0] + x[1] * x[1]) + (x[2] * x[2] + x[3] * x[3]); }
constexpr float NORM_EPS = 1e-6f;
__device__ __forceinline__ f32x4 lf2x4(const f32x4 x, const f32x4 lb) { f32x4 r;
#pragma unroll
    for (int i = 0; i < 4; ++i) { const float sg = __builtin_amdgcn_rcpf(1.0f + __builtin_amdgcn_exp2f(-1.4426950408889634f * x[i])); r[i] = __builtin_amdgcn_logf(lb[i] + (1.0f - lb[i]) * sg); }
    return r; }

struct EpiProj {
    static constexpr bool PERM = true, AFTER_DRAIN = false;
    bf16_t *QL, *KVL, *HQ, *FF, *FB, *HI, *HG, *KR; float *qss, *kvss; const float* cs; const float* lbv;
    __device__ __forceinline__ void operator()(const f32x4 (&acc)[2][2][4][2], const Unit& u, int wr, int wc, int fr, int fq) const {
        const int pn = u.pn, row0 = u.pm * BM + wr * 64 + fr, cl = wc * 32 + 8 * fq;
        if (pn == 23) {
            if (wc < 2) {
#pragma unroll
                for (int ai = 0; ai < 2; ++ai)
#pragma unroll
                    for (int m = 0; m < 4; ++m) { const int row = row0 + ai * HALF + m * 16; f32x4 a = acc[ai][0][m][0], b = acc[ai][0][m][1];
                        rope8(a, b, cs + (size_t)row * 64 + cl); *(u32x4*)(KR + (size_t)row * 64 + cl) = pack8(a, b); }
            }
            return;
        }
        bf16_t* base; int ldc, col; const float* lbp = nullptr;
        if (pn < 2) { base = QL; ldc = 512; col = pn * 256; }
        else if (pn == 2) { base = KVL; ldc = 256; col = 0; }
        else { const int s = (pn - 3) >> 2; base = s == 0 ? HQ : s == 1 ? FF : s == 2 ? FB : s == 3 ? HI : HG; ldc = 1024; col = ((pn - 3) & 3) * 256; if (s == 1 || s == 2) lbp = lbv + (s - 1) * 1024 + col + cl; }
#pragma unroll
        for (int ai = 0; ai < 2; ++ai)
#pragma unroll
            for (int m = 0; m < 4; ++m) { bf16_t* rowp = base + (size_t)(row0 + ai * HALF + m * 16) * ldc + col + cl;
#pragma unroll
                for (int bj = 0; bj < 2; ++bj) { f32x4 a = acc[ai][bj][m][0], b = acc[ai][bj][m][1];
                    if (lbp) { a = lf2x4(a, *(const f32x4*)(lbp + bj * HALF)); b = lf2x4(b, *(const f32x4*)(lbp + bj * HALF + 4)); }
                    *(u32x4*)(rowp + bj * HALF) = pack8(a, b); } }
        if (pn <= 2) {
#pragma unroll
            for (int ai = 0; ai < 2; ++ai)
#pragma unroll
                for (int m = 0; m < 4; ++m) { float s = (sq4(acc[ai][0][m][0]) + sq4(acc[ai][0][m][1])) + (sq4(acc[ai][1][m][0]) + sq4(acc[ai][1][m][1]));
                    s += __shfl_xor(s, 16); s += __shfl_xor(s, 32);
                    const int row = row0 + ai * HALF + m * 16;
                    if (fq == 0) { if (pn < 2) qss[(size_t)row * 8 + pn * 4 + wc] = s; else kvss[(size_t)row * 4 + wc] = s; } }
        }
    }
};
struct EpiQ {
    static constexpr bool PERM = true, AFTER_DRAIN = false;
    bf16_t *QN, *QR; const float* qss; const float* cs;
    __device__ __forceinline__ void operator()(const f32x4 (&acc)[2][2][4][2], const Unit& u, int wr, int wc, int fr, int fq) const {
        const int pn = u.pn, row0 = u.pm * BM + wr * 64 + fr, cl = wc * 32 + 8 * fq;
#pragma unroll
        for (int ai = 0; ai < 2; ++ai)
#pragma unroll
            for (int m = 0; m < 4; ++m) { const int row = row0 + ai * HALF + m * 16;
                const f32x4 s0 = *(const f32x4*)(qss + (size_t)row * 8), s1 = *(const f32x4*)(qss + (size_t)row * 8 + 4);
                const float rstd = 1.0f / sqrtf((((s0[0] + s0[1]) + (s0[2] + s0[3])) + ((s1[0] + s1[1]) + (s1[2] + s1[3]))) * (1.0f / 512.0f) + NORM_EPS);
                if (pn < 4) {
#pragma unroll
                    for (int bj = 0; bj < 2; ++bj) *(u32x4*)(QN + (size_t)row * 1024 + pn * 256 + bj * HALF + cl) = pack8(acc[ai][bj][m][0] * rstd, acc[ai][bj][m][1] * rstd);
                } else {
#pragma unroll
                    for (int bj = 0; bj < 2; ++bj) { f32x4 a = acc[ai][bj][m][0] * rstd, b = acc[ai][bj][m][1] * rstd;
                        rope8(a, b, cs + (size_t)row * 64 + (cl & 63)); *(u32x4*)(QR + (size_t)row * 512 + (pn - 4) * 256 + bj * HALF + cl) = pack8(a, b); }
                } }
    }
};
struct EpiKV {
    static constexpr bool PERM = true, AFTER_DRAIN = false;
    bf16_t *KN, *V; const float* kvss;
    __device__ __forceinline__ void operator()(const f32x4 (&acc)[2][2][4][2], const Unit& u, int wr, int wc, int fr, int fq) const {
        const int pn = u.pn, row0 = u.pm * BM + wr * 64 + fr, cl = wc * 32 + 8 * fq;
#pragma unroll
        for (int ai = 0; ai < 2; ++ai)
#pragma unroll
            for (int m = 0; m < 4; ++m) { const int row = row0 + ai * HALF + m * 16;
                const f32x4 s0 = *(const f32x4*)(kvss + (size_t)row * 4);
                const float rstd = 1.0f / sqrtf(((s0[0] + s0[1]) + (s0[2] + s0[3])) * (1.0f / 256.0f) + NORM_EPS);
                *(u32x4*)(KN + (size_t)row * 1024 + pn * HALF + cl) = pack8(acc[ai][0][m][0] * rstd, acc[ai][0][m][1] * rstd);
                *(u32x4*)(V + (size_t)row * 1024 + pn * HALF + cl) = pack8(acc[ai][1][m][0] * rstd, acc[ai][1][m][1] * rstd); }
    }
};
template <int ACT  , bool SS> struct EpiOut {
    static constexpr bool PERM = true, AFTER_DRAIN = false;
    bf16_t* O; int ldc; float* ss;
    __device__ __forceinline__ void operator()(const f32x4 (&acc)[2][2][4][2], const Unit& u, int wr, int wc, int fr, int fq) const {
        const int pn = u.pn, row0 = u.pm * BM + wr * 64 + fr, cl = wc * 32 + 8 * fq;
#pragma unroll
        for (int ai = 0; ai < 2; ++ai)
#pragma unroll
            for (int m = 0; m < 4; ++m) { const int row = row0 + ai * HALF + m * 16; bf16_t* rowp = O + (size_t)row * ldc + pn * BM + cl;
#pragma unroll
                for (int bj = 0; bj < 2; ++bj) { f32x4 a = acc[ai][bj][m][0], b = acc[ai][bj][m][1];
                    if (ACT == 1) { a = __builtin_elementwise_max(a, (f32x4){0.f, 0.f, 0.f, 0.f}); b = __builtin_elementwise_max(b, (f32x4){0.f, 0.f, 0.f, 0.f}); a = a * a; b = b * b; }
                    *(u32x4*)(rowp + bj * HALF) = pack8(a, b); }
                if (SS) { float s = (sq4(acc[ai][0][m][0]) + sq4(acc[ai][0][m][1])) + (sq4(acc[ai][1][m][0]) + sq4(acc[ai][1][m][1]));
                    s += __shfl_xor(s, 16); s += __shfl_xor(s, 32);
                    if (fq == 0) ss[(size_t)row * 32 + pn * 4 + wc] = s; } }
    }
};
template <class Epi, class Sched, bool ALIGN_EPI = false, bool SP2 = false>
__device__ __forceinline__ void gemm_phase(PG8_LAS unsigned char* lds, const Gemm g, const Sched& S, const Epi& E) {
    const int tid = threadIdx.x, wid = __builtin_amdgcn_readfirstlane(tid >> 6), lane = tid & 63, wr = wid >> 2, wc = wid & 3, fr = lane & 15, fq = lane >> 4;
    const int K = g.K, nt = K / BK;
    unsigned voffA[2], voffB[2];
#pragma unroll
    for (int i = 0; i < 2; ++i) { int R, C; stage_rc(tid * 16 + i * 8192, R, C); const int Rb = Epi::PERM ? ((R & ~31) + perm32(R & 31)) : R;
        voffA[i] = (unsigned)(R * K + C) * 2u; voffB[i] = (unsigned)(Rb * K + C) * 2u; }
    const size_t kstep = (size_t)(BK * 2);
    const size_t hstep = (size_t)HALF * K * 2;
    const size_t tstep = 2 * hstep;
    const unsigned ldsw = (unsigned)wid * 1024u;
    const int aoff = lds_byte(wr * 64 + fr, fq * 8), boff = lds_byte(wc * 32 + fr, fq * 8);
#define PG8_SA(b, h) (((b) * 2 + (h)) * HTB)
#define PG8_SB(b, h) ((4 + (b) * 2 + (h)) * HTB)
#define PG8_STAGE(bufoff, gbase, voff) do { _Pragma("unroll") for (int _i = 0; _i < 2; ++_i) \
        __builtin_amdgcn_global_load_lds((const unsigned*)((const char*)(gbase) + (voff)[_i]), (PG8_LAS unsigned*)(lds + (bufoff) + ldsw + _i * 8192), 16, 0, 0); } while (0)
#define PG8_LDA(dst, b, h) do { _Pragma("unroll") for (int m = 0; m < 4; ++m) _Pragma("unroll") for (int k = 0; k < 2; ++k) dst[m][k] = *(const PG8_LAS bf16x8*)(lds + PG8_SA(b, h) + aoff + m * 2048 + k * 1024); } while (0)
#define PG8_LDB(dst, b, h) do { _Pragma("unroll") for (int n = 0; n < 2; ++n) _Pragma("unroll") for (int k = 0; k < 2; ++k) dst[n][k] = *(const PG8_LAS bf16x8*)(lds + PG8_SB(b, h) + boff + n * 2048 + k * 1024); } while (0)
#define PG8_MMA(ai, bj, At, Bt) do { __builtin_amdgcn_s_setprio(1); _Pragma("unroll") for (int m = 0; m < 4; ++m) _Pragma("unroll") for (int n = 0; n < 2; ++n) _Pragma("unroll") for (int k = 0; k < 2; ++k) \
        acc[ai][bj][m][n] = __builtin_amdgcn_mfma_f32_16x16x32_bf16(Bt[n][k], At[m][k], acc[ai][bj][m][n], 0, 0, 0); __builtin_amdgcn_s_setprio(0); } while (0)
#define PG8_WAIT_V(n) asm volatile("s_waitcnt vmcnt(" #n ")" ::: "memory")
#define PG8_WAIT_L(n) asm volatile("s_waitcnt lgkmcnt(" #n ")" ::: "memory")
#define PG8_BAR __builtin_amdgcn_s_barrier()
#define PG8_SCHED __builtin_amdgcn_sched_barrier(0)
    Unit cur, nxt; int ui = 0;
    if (!S.next(0, cur)) return;
    f32x4 acc[2][2][4][2];
#pragma unroll
    for (int a = 0; a < 2; ++a)
#pragma unroll
        for (int b = 0; b < 2; ++b)
#pragma unroll
            for (int m = 0; m < 4; ++m)
#pragma unroll
                for (int n = 0; n < 2; ++n) acc[a][b][m][n] = (f32x4){0.f, 0.f, 0.f, 0.f};
    bf16x8 At[4][2], B0[2][2], B1[2][2];
    const char* cA = (const char*)g.A + (size_t)cur.pm * tstep; const char* cB = (const char*)g.Bt + (size_t)cur.pn * tstep;
    S.a_ready(cur);
    if constexpr (SP2) {
        PG8_STAGE(PG8_SB(0, 0), cB, voffB); PG8_STAGE(PG8_SB(0, 1), cB + hstep, voffB); PG8_STAGE(PG8_SA(0, 0), cA, voffA); PG8_STAGE(PG8_SA(0, 1), cA + hstep, voffA);
        if (wr == 1) PG8_BAR;
        PG8_WAIT_V(2); PG8_BAR;
        PG8_STAGE(PG8_SB(1, 0), cB + kstep, voffB); PG8_STAGE(PG8_SA(1, 0), cA + kstep, voffA); PG8_STAGE(PG8_SB(1, 1), cB + hstep + kstep, voffB);
        PG8_WAIT_V(6); PG8_BAR;
    } else {
        PG8_STAGE(PG8_SB(0, 0), cB, voffB); PG8_STAGE(PG8_SA(0, 0), cA, voffA); PG8_STAGE(PG8_SB(0, 1), cB + hstep, voffB); PG8_STAGE(PG8_SA(0, 1), cA + hstep, voffA);
        if (wr == 1) PG8_BAR;
        PG8_WAIT_V(4); PG8_BAR;
        PG8_STAGE(PG8_SB(1, 0), cB + kstep, voffB); PG8_STAGE(PG8_SA(1, 0), cA + kstep, voffA); PG8_STAGE(PG8_SB(1, 1), cB + hstep + kstep, voffB);
        PG8_WAIT_V(6); PG8_BAR;
    }
    for (;;) {
        const bool has_next = S.next(ui + 1, nxt);
        const char* nA = has_next ? (const char*)g.A + (size_t)nxt.pm * tstep : cA; const char* nB = has_next ? (const char*)g.Bt + (size_t)nxt.pn * tstep : cB;
        for (int t = 0; t < nt; t += 2) {
            const bool last = (t == nt - 2);
            const char* a1 = cA + (size_t)(t + 1) * kstep;
            const char* a2 = last ? nA : cA + (size_t)(t + 2) * kstep; const char* b2 = last ? nB : cB + (size_t)(t + 2) * kstep;
            const char* a3 = a2 + kstep; const char* b3 = b2 + kstep;
            if (last && has_next) S.a_ready(nxt);
            if constexpr (SP2) {
            PG8_LDB(B0, 0, 0); PG8_LDB(B1, 0, 1); PG8_SCHED; PG8_LDA(At, 0, 0); PG8_STAGE(PG8_SA(1, 1), a1 + hstep, voffA);
            PG8_WAIT_V(8); PG8_WAIT_L(0); PG8_BAR; PG8_MMA(0, 0, At, B0); PG8_MMA(0, 1, At, B1); PG8_BAR; PG8_SCHED;
            PG8_LDA(At, 0, 1); PG8_STAGE(PG8_SB(0, 0), b2, voffB); PG8_STAGE(PG8_SB(0, 1), b2 + hstep, voffB); PG8_STAGE(PG8_SA(0, 0), a2, voffA);
            PG8_WAIT_V(8); PG8_WAIT_L(0); PG8_BAR; PG8_MMA(1, 0, At, B0); PG8_MMA(1, 1, At, B1); PG8_BAR; PG8_SCHED;
            PG8_LDB(B0, 1, 0); PG8_LDB(B1, 1, 1); PG8_SCHED; PG8_LDA(At, 1, 0); PG8_STAGE(PG8_SA(0, 1), a2 + hstep, voffA);
            PG8_WAIT_V(8); PG8_WAIT_L(0); PG8_BAR; PG8_MMA(0, 0, At, B0); PG8_MMA(0, 1, At, B1); PG8_BAR; PG8_SCHED;
            PG8_LDA(At, 1, 1); PG8_STAGE(PG8_SB(1, 0), b3, voffB); PG8_STAGE(PG8_SB(1, 1), b3 + hstep, voffB); PG8_STAGE(PG8_SA(1, 0), a3, voffA);
            PG8_WAIT_V(8); PG8_WAIT_L(0); PG8_BAR; PG8_MMA(1, 0, At, B0); PG8_MMA(1, 1, At, B1); PG8_BAR; PG8_SCHED;
            } else {
            PG8_LDB(B0, 0, 0); PG8_SCHED; PG8_LDA(At, 0, 0); PG8_STAGE(PG8_SA(1, 1), a1 + hstep, voffA);
            PG8_WAIT_L(8); PG8_BAR; PG8_WAIT_L(0); PG8_MMA(0, 0, At, B0); PG8_BAR; PG8_SCHED;
            PG8_LDB(B1, 0, 1); PG8_STAGE(PG8_SB(0, 0), b2, voffB);
            PG8_BAR; PG8_WAIT_L(0); PG8_MMA(0, 1, At, B1); PG8_BAR;
            PG8_LDA(At, 0, 1); PG8_STAGE(PG8_SA(0, 0), a2, voffA);
            PG8_BAR; PG8_WAIT_L(0); PG8_MMA(1, 0, At, B0); PG8_BAR; PG8_SCHED;
            PG8_STAGE(PG8_SB(0, 1), b2 + hstep, voffB);
            PG8_WAIT_V(6); PG8_BAR; PG8_MMA(1, 1, At, B1); PG8_BAR;
            PG8_LDB(B0, 1, 0); PG8_SCHED; PG8_LDA(At, 1, 0); PG8_STAGE(PG8_SA(0, 1), a2 + hstep, voffA);
            PG8_WAIT_L(8); PG8_BAR; PG8_WAIT_L(0); PG8_MMA(0, 0, At, B0); PG8_BAR; PG8_SCHED;
            PG8_LDB(B1, 1, 1); PG8_STAGE(PG8_SB(1, 0), b3, voffB);
            PG8_BAR; PG8_WAIT_L(0); PG8_MMA(0, 1, At, B1); PG8_BAR;
            PG8_LDA(At, 1, 1); PG8_STAGE(PG8_SA(1, 0), a3, voffA);
            PG8_BAR; PG8_WAIT_L(0); PG8_MMA(1, 0, At, B0); PG8_BAR; PG8_SCHED;
            PG8_STAGE(PG8_SB(1, 1), b3 + hstep, voffB);
            PG8_WAIT_V(6); PG8_BAR; PG8_MMA(1, 1, At, B1); PG8_BAR;
            }
        }
        if constexpr (ALIGN_EPI) { if (wr == 0) PG8_BAR; }
        if constexpr (!Epi::AFTER_DRAIN) { E(acc, cur, wr, wc, fr, fq); S.done(cur); }
        if (!has_next) break;
#pragma unroll
        for (int a = 0; a < 2; ++a)
#pragma unroll
            for (int b = 0; b < 2; ++b)
#pragma unroll
                for (int m = 0; m < 4; ++m)
#pragma unroll
                    for (int n = 0; n < 2; ++n) acc[a][b][m][n] = (f32x4){0.f, 0.f, 0.f, 0.f};
        cur = nxt; cA = nA; cB = nB; ++ui;
        if constexpr (ALIGN_EPI) { if (wr == 1) PG8_BAR; }
    }
    PG8_WAIT_V(0);
    if constexpr (!ALIGN_EPI) { if (wr == 0) PG8_BAR; }
    PG8_BAR;
    if constexpr (Epi::AFTER_DRAIN) { E.fused(acc, cur, wr, wc, fr, fq, lds, wid, lane); S.done(cur); }
#undef PG8_SA
#undef PG8_SB
#undef PG8_STAGE
#undef PG8_LDA
#undef PG8_LDB
#undef PG8_MMA
#undef PG8_WAIT_V
#undef PG8_WAIT_L
#undef PG8_BAR
#undef PG8_SCHED
}
}
#define PG8_SP2 true
#define PG8_ALIGN true
namespace att {
using bf16x8 = __attribute__((ext_vector_type(8))) short;
using s16x4  = __attribute__((ext_vector_type(4))) short;
using f32x16 = __attribute__((ext_vector_type(16))) float;
using u32x4  = __attribute__((ext_vector_type(4))) unsigned;
constexpr int NW = 8, QBLK = 32, KVBLK = 64, SEQ = 4096;
constexpr float SCALE = 0.07216878364870322f;
constexpr float THR = 8.f;
#ifndef ATT_SDEPTH
#define ATT_SDEPTH 1
#endif
#ifndef QKT_SB
#define QKT_SB 0
#endif
constexpr int SDEPTH = ATT_SDEPTH;
constexpr int SHM_V = 16384, SHM_KN = 64 * 272, SHM_KR = 64 * 144;
constexpr int OFF_V = 0, OFF_KN = 2 * SHM_V, OFF_KR = OFF_KN + 2 * SHM_KN, OFF_WS = OFF_KR + 2 * SHM_KR, OFF_QR = OFF_WS + NW * 64 * 4, LDS_BYTES = OFF_QR + NW * 4096;
#define KSWZ(row, colB) ((row) * 272 + (colB))
#define KRSWZ(row, colB) ((row) * 144 + (colB))
#define SBAR() __builtin_amdgcn_sched_barrier(0)
__device__ __forceinline__ int crow(int r, int hi) { return (r & 3) + 8 * (r >> 2) + 4 * hi; }
__device__ __forceinline__ unsigned cvtpk(float lo, float hi) { unsigned r; asm volatile("v_cvt_pk_bf16_f32 %0, %1, %2" : "=v"(r) : "v"(lo), "v"(hi)); return r; }
__device__ __forceinline__ void partialSM(f32x16& p0, f32x16& p1, float& m_reg, float& mn, float& alpha) {
  constexpr float C = SCALE * 1.4426950408889634f;
  float pmax = p0[0]; for (int r = 1; r < 16; ++r) pmax = fmaxf(pmax, p0[r]); for (int r = 0; r < 16; ++r) pmax = fmaxf(pmax, p1[r]);
  { auto rr = __builtin_amdgcn_permlane32_swap(__float_as_uint(pmax), __float_as_uint(pmax), false, false);
    pmax = fmaxf(__uint_as_float(rr[0]), __uint_as_float(rr[1])); }
  if (__builtin_expect(__all(pmax - m_reg <= THR / SCALE), 1)) { mn = m_reg; alpha = 1.f; }
  else { mn = fmaxf(m_reg, pmax); alpha = __builtin_amdgcn_exp2f((m_reg - mn) * C); m_reg = mn; }
  float mnC = -mn * C;
  for (int r = 0; r < 16; ++r) p0[r] = fmaf(p0[r], C, mnC); for (int r = 0; r < 16; ++r) p1[r] = fmaf(p1[r], C, mnC);
  for (int r = 0; r < 16; ++r) p0[r] = __builtin_amdgcn_exp2f(p0[r]);
}
__device__ __forceinline__ void finishSM(f32x16& p0, f32x16& p1, float alpha, float& l_reg, bf16x8& pa0, bf16x8& pa1, bf16x8& pa2, bf16x8& pa3) {
  for (int r = 0; r < 16; ++r) p1[r] = __builtin_amdgcn_exp2f(p1[r]);
  float ps = 0; for (int r = 0; r < 16; ++r) ps += p0[r]; for (int r = 0; r < 16; ++r) ps += p1[r];
  { auto rr = __builtin_amdgcn_permlane32_swap(__float_as_uint(ps), __float_as_uint(ps), false, false);
    ps = __uint_as_float(rr[0]) + __uint_as_float(rr[1]); }
  l_reg = l_reg * alpha + ps;
#define PK4(P, BASE, OUT) do { unsigned a0 = cvtpk(P[BASE + 0], P[BASE + 1]), a1 = cvtpk(P[BASE + 2], P[BASE + 3]);   \
    unsigned b0 = cvtpk(P[BASE + 4], P[BASE + 5]), b1 = cvtpk(P[BASE + 6], P[BASE + 7]);                              \
    auto r0 = __builtin_amdgcn_permlane32_swap(a0, b0, false, false); auto r1 = __builtin_amdgcn_permlane32_swap(a1, b1, false, false); \
    u32x4 w = {r0[0], r1[0], r0[1], r1[1]}; OUT = *reinterpret_cast<bf16x8*>(&w); } while (0)
  PK4(p0, 0, pa0); PK4(p0, 8, pa1); PK4(p1, 0, pa2); PK4(p1, 8, pa3);
#undef PK4
}
__device__ __forceinline__ void qkt(f32x16& p0, f32x16& p1, const char* Kn, const char* Kr, const bf16x8* qr, const char* qrl, int r32, int hi) {
  p0 = f32x16{}; p1 = f32x16{};
#pragma unroll
  for (int d0 = 0; d0 < 8; ++d0) { const int cb = (d0 * 16 + hi * 8) * 2;
    const bf16x8 b0 = *reinterpret_cast<const bf16x8*>(Kn + KSWZ(r32, cb));
    const bf16x8 b1 = *reinterpret_cast<const bf16x8*>(Kn + KSWZ(32 + r32, cb));
    p0 = __builtin_amdgcn_mfma_f32_32x32x16_bf16(b0, qr[d0], p0, 0, 0, 0);
    p1 = __builtin_amdgcn_mfma_f32_32x32x16_bf16(b1, qr[d0], p1, 0, 0, 0);
    if (QKT_SB && (d0 & 3) == 3) SBAR(); }
#pragma unroll
  for (int d0 = 0; d0 < 4; ++d0) { const int cb = (d0 * 16 + hi * 8) * 2;
    const bf16x8 b0 = *reinterpret_cast<const bf16x8*>(Kr + KRSWZ(r32, cb));
    const bf16x8 b1 = *reinterpret_cast<const bf16x8*>(Kr + KRSWZ(32 + r32, cb));
    const bf16x8 qf = *reinterpret_cast<const bf16x8*>(qrl + d0 * 1024);
    p0 = __builtin_amdgcn_mfma_f32_32x32x16_bf16(b0, qf, p0, 0, 0, 0);
    p1 = __builtin_amdgcn_mfma_f32_32x32x16_bf16(b1, qf, p1, 0, 0, 0); }
}
__device__ __forceinline__ int v_st(int k, int c) { const int kk = (k & ~0xC) | ((k & 4) << 1) | ((k & 8) >> 1); return ((kk >> 3) * 4 + (c >> 5)) * 512 + ((kk & 7) * 32 + (c & 31)) * 2; }
__device__ __forceinline__ int v_rd_base(int lane) { return ((lane & 3) << 3) | (((lane >> 2) & 3) << 6) | (((lane >> 4) & 1) << 5) | (((lane >> 5) & 1) << 8); }
constexpr int v_rd_off(int d0, int ks, int half) { return d0 * 512 + ks * 4096 + half * 2048; }
template <int OFF> __device__ __forceinline__ s16x4 tr_read(int vb) {
  s16x4 r; asm volatile("ds_read_b64_tr_b16 %0, %1 offset:%2" : "=&v"(r) : "v"(vb), "i"(OFF) : "memory"); return r;
}
template <int D0> __device__ __forceinline__ void pv_one(f32x16& od, int vb, bf16x8 pa0, bf16x8 pa1, bf16x8 pa2, bf16x8 pa3) {
  const s16x4 l0 = tr_read<v_rd_off(D0, 0, 0)>(vb), h0 = tr_read<v_rd_off(D0, 0, 1)>(vb), l1 = tr_read<v_rd_off(D0, 1, 0)>(vb), h1 = tr_read<v_rd_off(D0, 1, 1)>(vb);
  const s16x4 l2 = tr_read<v_rd_off(D0, 2, 0)>(vb), h2 = tr_read<v_rd_off(D0, 2, 1)>(vb), l3 = tr_read<v_rd_off(D0, 3, 0)>(vb), h3 = tr_read<v_rd_off(D0, 3, 1)>(vb);
  asm volatile("s_waitcnt lgkmcnt(0)" ::: "memory"); SBAR();
#define PK(L, H) (bf16x8){L[0], L[1], L[2], L[3], H[0], H[1], H[2], H[3]}
  od = __builtin_amdgcn_mfma_f32_32x32x16_bf16(pa0, PK(l0, h0), od, 0, 0, 0);
  od = __builtin_amdgcn_mfma_f32_32x32x16_bf16(pa1, PK(l1, h1), od, 0, 0, 0);
  od = __builtin_amdgcn_mfma_f32_32x32x16_bf16(pa2, PK(l2, h2), od, 0, 0, 0);
  od = __builtin_amdgcn_mfma_f32_32x32x16_bf16(pa3, PK(l3, h3), od, 0, 0, 0);
#undef PK
}
__device__ __forceinline__ void pv_d0(f32x16* o, int vb, bf16x8 pa0, bf16x8 pa1, bf16x8 pa2, bf16x8 pa3) {
  pv_one<0>(o[0], vb, pa0, pa1, pa2, pa3); pv_one<1>(o[1], vb, pa0, pa1, pa2, pa3); pv_one<2>(o[2], vb, pa0, pa1, pa2, pa3); pv_one<3>(o[3], vb, pa0, pa1, pa2, pa3);
}
struct Tens { const short* QN; const short* QR; const short* KN; const short* KR; const short* V; unsigned short* O; };
__device__ __forceinline__ unsigned short f2bf_rne(float f) { unsigned u = __builtin_bit_cast(unsigned, f); return (unsigned short)((u + 0x7fffu + ((u >> 16) & 1u)) >> 16); }
__device__ __forceinline__ void attn_unit(int b, int h, int qb, const Tens& T, char* lds) {
  int tid = threadIdx.x; asm volatile("" : "+v"(tid));
  const int wid = tid >> 6, lane = tid & 63, r32 = lane & 31, hi = lane >> 5;
  char* V_lds = lds + OFF_V; char* KN_lds = lds + OFF_KN; char* KR_lds = lds + OFF_KR;
  char* qrl = lds + OFF_QR + wid * 4096 + lane * 16; float* ws = (float*)(lds + OFF_WS) + wid * 64; float* li_l = ws; float* al_l = ws + 32;
  float m_reg = -1e30f, l_reg = 0; f32x16 o[4] = {}; bf16x8 qr[8];
  const long rowbase = (long)b * SEQ, qrow = rowbase + qb * 256 + wid * QBLK + r32;
  { const short* Qn = T.QN + qrow * 1024 + h * 128 + hi * 8; const short* Qr = T.QR + qrow * 512 + h * 64 + hi * 8;
#pragma unroll
    for (int d0 = 0; d0 < 8; ++d0) qr[d0] = *reinterpret_cast<const bf16x8*>(Qn + d0 * 16);
#pragma unroll
    for (int d0 = 0; d0 < 4; ++d0) *reinterpret_cast<bf16x8*>(qrl + d0 * 1024) = *reinterpret_cast<const bf16x8*>(Qr + d0 * 16); }
  const short* Kn = T.KN + rowbase * 1024 + h * 128; const short* Vh = T.V + rowbase * 1024 + h * 128; const short* Kr = T.KR + rowbase * 64;
  const int sr = tid >> 4, sc = (tid & 15) * 8, vst0 = v_st(sr, sc), vst1 = v_st(32 + sr, sc);
  const int krr = tid >> 3, krc = (tid & 7) * 8;
  const int vb0 = (int)(uintptr_t)V_lds + v_rd_base(lane);
  struct { bf16x8 vs0, vs1, ks0, ks1, kr; } sr_[SDEPTH];
#define LD8(p) (*reinterpret_cast<const bf16x8*>(p))
#define SLOAD(i, k0) do { sr_[i].vs0 = LD8(&Vh[(long)((k0) + sr) * 1024 + sc]); sr_[i].vs1 = LD8(&Vh[(long)((k0) + 32 + sr) * 1024 + sc]); \
    sr_[i].ks0 = LD8(&Kn[(long)((k0) + sr) * 1024 + sc]); sr_[i].ks1 = LD8(&Kn[(long)((k0) + 32 + sr) * 1024 + sc]); sr_[i].kr = LD8(&Kr[(long)((k0) + krr) * 64 + krc]); } while (0)
#define SWRITE(bb, i) do { *(bf16x8*)(V_lds + (bb) * SHM_V + vst0) = sr_[i].vs0; *(bf16x8*)(V_lds + (bb) * SHM_V + vst1) = sr_[i].vs1; const int kc = sc * 2; \
    *(bf16x8*)(KN_lds + (bb) * SHM_KN + KSWZ(sr, kc)) = sr_[i].ks0; *(bf16x8*)(KN_lds + (bb) * SHM_KN + KSWZ(32 + sr, kc)) = sr_[i].ks1; \
    *(bf16x8*)(KR_lds + (bb) * SHM_KR + KRSWZ(krr, krc * 2)) = sr_[i].kr; } while (0)
#define SWAIT() do { if constexpr (SDEPTH == 2) asm volatile("s_waitcnt vmcnt(5)" ::: "memory"); else asm volatile("s_waitcnt vmcnt(0)" ::: "memory"); } while (0)
#define RESC(a) do { if (__any((a) < 1.f)) { if (hi == 0) al_l[r32] = (a); asm volatile("s_waitcnt lgkmcnt(0)" ::: "memory"); \
    for (int d = 0; d < 4; ++d) for (int r = 0; r < 16; ++r) o[d][r] *= al_l[crow(r, hi)]; } } while (0)
  f32x16 pA0, pA1, pB0, pB1; float mnA, mnB, alA, alB; bf16x8 pa0, pa1, pa2, pa3; constexpr int NT = SEQ / KVBLK;
  constexpr int SE = 0, SO = SDEPTH - 1;
  SLOAD(SE, 0); asm volatile("s_waitcnt vmcnt(0)" ::: "memory"); SWRITE(0, SE); __syncthreads();
  qkt(pA0, pA1, KN_lds, KR_lds, qr, qrl, r32, hi); partialSM(pA0, pA1, m_reg, mnA, alA);
  SLOAD(SO, KVBLK); if constexpr (SDEPTH == 2) { if (2 < NT) SLOAD(SE, 2 * KVBLK); }
  SWAIT(); SWRITE(1, SO); __syncthreads();
  for (int j = 1; j + 1 < NT; j += 2) {
    SBAR(); qkt(pB0, pB1, KN_lds + SHM_KN, KR_lds + SHM_KR, qr, qrl, r32, hi);
    finishSM(pA0, pA1, alA, l_reg, pa0, pa1, pa2, pa3); SBAR();
    SLOAD(SO, (j + SDEPTH) * KVBLK); SBAR();
    pv_d0(o, vb0, pa0, pa1, pa2, pa3); partialSM(pB0, pB1, m_reg, mnB, alB);
    __syncthreads(); SWAIT(); SWRITE(0, SE);
    RESC(alB); __syncthreads();
    SBAR(); qkt(pA0, pA1, KN_lds, KR_lds, qr, qrl, r32, hi);
    finishSM(pB0, pB1, alB, l_reg, pa0, pa1, pa2, pa3); SBAR();
    if (SDEPTH == 1 || j + 3 < NT) SLOAD(SE, (j + 1 + SDEPTH) * KVBLK); SBAR();
    pv_d0(o, vb0 + SHM_V, pa0, pa1, pa2, pa3); partialSM(pA0, pA1, m_reg, mnA, alA);
    __syncthreads(); SWAIT(); SWRITE(1, SO);
    RESC(alA); __syncthreads();
  }
  SBAR(); qkt(pB0, pB1, KN_lds + SHM_KN, KR_lds + SHM_KR, qr, qrl, r32, hi);
  finishSM(pA0, pA1, alA, l_reg, pa0, pa1, pa2, pa3); SBAR();
  pv_d0(o, vb0, pa0, pa1, pa2, pa3); partialSM(pB0, pB1, m_reg, mnB, alB);
  __syncthreads(); RESC(alB);
  finishSM(pB0, pB1, alB, l_reg, pa0, pa1, pa2, pa3); SBAR();
  pv_d0(o, vb0 + SHM_V, pa0, pa1, pa2, pa3);
  if (hi == 0) li_l[r32] = l_reg; asm volatile("s_waitcnt lgkmcnt(0)" ::: "memory");
  float rli[16];
#pragma unroll
  for (int r = 0; r < 16; ++r) rli[r] = __builtin_amdgcn_rcpf(li_l[crow(r, hi)]);
  __syncthreads();
  { unsigned short* stg = (unsigned short*)(lds + wid * 8192);
#pragma unroll
    for (int r = 0; r < 16; ++r) { const int orow = crow(r, hi);
#pragma unroll
      for (int d0 = 0; d0 < 4; ++d0) stg[orow * 128 + d0 * 32 + r32] = f2bf_rne(o[d0][r] * rli[r]); }
    asm volatile("s_waitcnt lgkmcnt(0)" ::: "memory");
    unsigned short* Ow = T.O + (rowbase + qb * 256 + wid * QBLK) * 2048 + h * 128;
#pragma unroll
    for (int i = 0; i < 8; ++i) { const int row = i * 4 + (lane >> 4), ch = lane & 15; const u32x4 v = *(const u32x4*)(stg + row * 128 + ch * 8); *(u32x4*)(Ow + (long)row * 2048 + ch * 8) = v; } }
  __syncthreads();
#undef LD8
#undef SLOAD
#undef SWRITE
#undef SWAIT
#undef RESC
}
#undef KSWZ
#undef KRSWZ
#undef SBAR
}
namespace hg {
typedef short bf16x8 __attribute__((ext_vector_type(8)));
typedef short s16x4 __attribute__((ext_vector_type(4)));
typedef float f32x4 __attribute__((ext_vector_type(4)));
typedef float f32x2 __attribute__((ext_vector_type(2)));
typedef unsigned u32x4 __attribute__((ext_vector_type(4)));
typedef unsigned u32x2 __attribute__((ext_vector_type(2)));
typedef __attribute__((address_space(3))) s16x4* lds_s16x4_ptr;
constexpr int SQ = 272, IMG = 64 * SQ, ST = 144;
constexpr int OFF_IMG = 0, OFF_AM = 6 * IMG, OFF_TOT = OFF_AM + 64 * ST, OFF_DEC = OFF_TOT + 8 * 128 * 4, LDS_BYTES = OFF_DEC + 2 * 512;
constexpr int NSEG = 4, CPS = 16;
typedef float f32x2_t __attribute__((ext_vector_type(2))); typedef __bf16 bf16x2_t __attribute__((ext_vector_type(2)));
__device__ __forceinline__ unsigned pkbf(float lo, float hi) { f32x2_t v = {lo, hi}; bf16x2_t bb = __builtin_convertvector(v, bf16x2_t); return __builtin_bit_cast(unsigned, bb); }
__device__ __forceinline__ float blo(unsigned w) { return __builtin_bit_cast(float, w << 16); }
__device__ __forceinline__ float bhi(unsigned w) { return __builtin_bit_cast(float, w & 0xffff0000u); }
__device__ __forceinline__ s16x4 trrd(const char* p) { return __builtin_amdgcn_ds_read_tr16_b64_v4i16((lds_s16x4_ptr)p); }
template <bool STATE_ONLY>
__device__ __forceinline__ void hgrn_seg(int ch, int seg, const unsigned short* HQ, const unsigned short* FX, const unsigned short* HI, unsigned short* OD, float* SLOC, float* DSEG, char* lds) {
  constexpr int SEQ = 4096;
  const int b = ch >> 4, h = (ch >> 1) & 7, dir = ch & 1;
  const int tid = threadIdx.x, lane = tid & 63, w = __builtin_amdgcn_readfirstlane(tid >> 6), l15 = lane & 15, lg = lane >> 4, tq = (lane & 15) >> 2, tp = lane & 3;
  char* AM = lds + OFF_AM; float* TOT = (float*)(lds + OFF_TOT); float* DEC = (float*)(lds + OFF_DEC);
  const size_t cb = (size_t)h * 128; const long rb = (long)b * SEQ; const int c0 = seg * CPS;
#define ROWOF(t) ((size_t)(rb + (dir ? (SEQ - 1 - (t)) : (t))))
  unsigned lfr[8], qr[8]; u32x4 vr[2];
  float cs0[8], cs1[8]; unsigned qs[8]; u32x4 vs[2];
  float ltot0 = 0.f, ltot1 = 0.f;
  f32x4 S[8];
#pragma unroll
  for (int T = 0; T < 8; ++T) S[T] = (f32x4){0.f, 0.f, 0.f, 0.f};
  if (!STATE_ONLY && seg > 0) {
#pragma unroll 1
    for (int g = 0; g < seg; ++g) { const float* sl = SLOC + (size_t)((ch * 3 + g) * 8 + w) * 2048 + lane; const float* dg = DSEG + (ch * 3 + g) * 128 + 4 * lg;
#pragma unroll
      for (int T = 0; T < 8; ++T) { const f32x4 dv = *(const f32x4*)(dg + 16 * T); f32x4 pv;
#pragma unroll
        for (int r = 0; r < 4; ++r) pv[r] = sl[(T * 4 + r) * 64];
        if (g > 0) S[T] = S[T] * dv + pv; else S[T] = pv; } }
  }
#define LOADS(cc) do { _Pragma("unroll") for (int i = 0; i < 8; ++i) { const size_t ro = ROWOF(64 * (cc) + 8 * w + i) * 1024 + cb + 2 * lane; lfr[i] = *(const unsigned*)(FX + ro); if (!STATE_ONLY) qr[i] = *(const unsigned*)(HQ + ro); } \
    _Pragma("unroll") for (int jj = 0; jj < 2; ++jj) { const int idx = tid + 512 * jj; vr[jj] = *(const u32x4*)(HI + ROWOF(64 * (cc) + (idx >> 4)) * 1024 + cb + 8 * (idx & 15)); } } while (0)
#define PRE() do { float a0 = 0.f, a1 = 0.f; _Pragma("unroll") for (int i = 0; i < 8; ++i) { a0 += blo(lfr[i]); a1 += bhi(lfr[i]); cs0[i] = a0; cs1[i] = a1; if (!STATE_ONLY) qs[i] = qr[i]; } \
    vs[0] = vr[0]; vs[1] = vr[1]; *(f32x2*)(TOT + w * 128 + 2 * lane) = (f32x2){a0, a1}; } while (0)
#define POST(par) do { char* QDn = lds + (par) * 3 * IMG; char* KDn = QDn + IMG; char* VIn = QDn + 2 * IMG; \
    float o0 = 0.f, o1 = 0.f, t0 = 0.f, t1 = 0.f; _Pragma("unroll") for (int ww = 0; ww < 8; ++ww) { const f32x2 tv = *(const f32x2*)(TOT + ww * 128 + 2 * lane); if (ww < w) { o0 += tv.x; o1 += tv.y; } t0 += tv.x; t1 += tv.y; } \
    if (w == 0) { *(f32x2*)(DEC + (par) * 128 + 2 * lane) = (f32x2){__builtin_amdgcn_exp2f(t0), __builtin_amdgcn_exp2f(t1)}; ltot0 += t0; ltot1 += t1; } \
    float p0 = __builtin_amdgcn_exp2f(-o0), p1 = __builtin_amdgcn_exp2f(-o1); \
    _Pragma("unroll") for (int i = 0; i < 8; ++i) { const float b0 = o0 + cs0[i], b1 = o1 + cs1[i]; const float n0 = __builtin_amdgcn_exp2f(-b0), n1 = __builtin_amdgcn_exp2f(-b1); \
      *(unsigned*)(KDn + (8 * w + i) * SQ + 4 * lane) = pkbf(n0 - p0, n1 - p1); p0 = n0; p1 = n1; \
      if (!STATE_ONLY) { const float e0 = __builtin_amdgcn_exp2f(b0), e1 = __builtin_amdgcn_exp2f(b1); *(unsigned*)(QDn + (8 * w + i) * SQ + 4 * lane) = pkbf(blo(qs[i]) * e0, bhi(qs[i]) * e1); } } \
    _Pragma("unroll") for (int jj = 0; jj < 2; ++jj) { const int idx = tid + 512 * jj; *(u32x4*)(VIn + (idx >> 4) * SQ + (idx & 15) * 16) = vs[jj]; } } while (0)
  LOADS(c0); PRE();
  LOADS(c0 + 1);
  __syncthreads();
  POST(0);
  __syncthreads();
#pragma unroll 1
  for (int ci = 0; ci < CPS; ++ci) {
    const int c = c0 + ci, par = ci & 1;
    char* QD = lds + par * 3 * IMG; char* KD = QD + IMG; char* VI = QD + 2 * IMG;
    if (!STATE_ONLY) { const int ttile = w >> 1;
#pragma unroll
      for (int ss = 0; ss < 2; ++ss) { const int stile = 2 * (w & 1) + ss; f32x4 acc = {0.f, 0.f, 0.f, 0.f};
        if (stile <= ttile) {
#pragma unroll
          for (int ks = 0; ks < 4; ++ks) { const bf16x8 a = *(const bf16x8*)(KD + (16 * stile + l15) * SQ + (32 * ks + 8 * lg) * 2); const bf16x8 bq = *(const bf16x8*)(QD + (16 * ttile + l15) * SQ + (32 * ks + 8 * lg) * 2);
            acc = __builtin_amdgcn_mfma_f32_16x16x32_bf16(a, bq, acc, 0, 0, 0); } }
        const int t = 16 * ttile + l15, s0 = 16 * stile + 4 * lg;
#pragma unroll
        for (int r = 0; r < 4; ++r) if (s0 + r > t) acc[r] = 0.f;
        u32x2 pw; pw.x = pkbf(acc[0], acc[1]); pw.y = pkbf(acc[2], acc[3]); *(u32x2*)(AM + t * ST + s0 * 2) = pw; } }
    if (ci + 1 < CPS) { PRE(); if (ci + 2 < CPS) LOADS(c + 2); }
    __syncthreads();
    { bf16x8 vb[2];
#pragma unroll
      for (int ks = 0; ks < 2; ++ks) { const s16x4 lo = trrd(VI + (32 * ks + 8 * lg + tq) * SQ + (16 * w + 4 * tp) * 2), hi = trrd(VI + (32 * ks + 8 * lg + 4 + tq) * SQ + (16 * w + 4 * tp) * 2);
        vb[ks] = (bf16x8){lo[0], lo[1], lo[2], lo[3], hi[0], hi[1], hi[2], hi[3]}; }
      if (!STATE_ONLY) { f32x4 o[4];
#pragma unroll
        for (int tt = 0; tt < 4; ++tt) o[tt] = (f32x4){0.f, 0.f, 0.f, 0.f};
#pragma unroll
        for (int ks = 0; ks < 2; ++ks)
#pragma unroll
          for (int tt = 0; tt < 4; ++tt) { if (ks == 1 && tt < 2) continue; const bf16x8 a = *(const bf16x8*)(AM + (16 * tt + l15) * ST + (32 * ks + 8 * lg) * 2); o[tt] = __builtin_amdgcn_mfma_f32_16x16x32_bf16(a, vb[ks], o[tt], 0, 0, 0); }
#pragma unroll
        for (int ks = 0; ks < 4; ++ks) { u32x4 sw; sw.x = pkbf(S[2 * ks][0], S[2 * ks][1]); sw.y = pkbf(S[2 * ks][2], S[2 * ks][3]); sw.z = pkbf(S[2 * ks + 1][0], S[2 * ks + 1][1]); sw.w = pkbf(S[2 * ks + 1][2], S[2 * ks + 1][3]);
          const bf16x8 sb = __builtin_bit_cast(bf16x8, sw);
#pragma unroll
          for (int tt = 0; tt < 4; ++tt) { const u32x2 alo = *(const u32x2*)(QD + (16 * tt + l15) * SQ + (32 * ks + 4 * lg) * 2), ahi = *(const u32x2*)(QD + (16 * tt + l15) * SQ + (32 * ks + 16 + 4 * lg) * 2);
            const u32x4 aw = {alo.x, alo.y, ahi.x, ahi.y}; o[tt] = __builtin_amdgcn_mfma_f32_16x16x32_bf16(__builtin_bit_cast(bf16x8, aw), sb, o[tt], 0, 0, 0); } }
#pragma unroll
        for (int tt = 0; tt < 4; ++tt)
#pragma unroll
          for (int r = 0; r < 4; ++r) OD[ROWOF(64 * c + 16 * tt + 4 * lg + r) * 1024 + cb + 16 * w + l15] = (unsigned short)(pkbf(o[tt][r], 0.f) & 0xffffu); }
#pragma unroll
      for (int T = 0; T < 8; ++T) {
#pragma unroll
        for (int ks = 0; ks < 2; ++ks) { const s16x4 lo = trrd(KD + (32 * ks + 8 * lg + tq) * SQ + (16 * T + 4 * tp) * 2), hi = trrd(KD + (32 * ks + 8 * lg + 4 + tq) * SQ + (16 * T + 4 * tp) * 2);
          const bf16x8 a = {lo[0], lo[1], lo[2], lo[3], hi[0], hi[1], hi[2], hi[3]}; S[T] = __builtin_amdgcn_mfma_f32_16x16x32_bf16(a, vb[ks], S[T], 0, 0, 0); }
        const f32x4 dv = *(const f32x4*)(DEC + par * 128 + 16 * T + 4 * lg); S[T] = S[T] * dv; } }
    if (ci + 1 < CPS) POST(par ^ 1);
    __syncthreads();
  }
  if (STATE_ONLY) {
    float* sl = SLOC + (size_t)((ch * 3 + seg) * 8 + w) * 2048 + lane;
#pragma unroll
    for (int T = 0; T < 8; ++T)
#pragma unroll
      for (int r = 0; r < 4; ++r) sl[(T * 4 + r) * 64] = S[T][r];
    if (w == 0) *(f32x2*)(DSEG + (ch * 3 + seg) * 128 + 2 * lane) = (f32x2){__builtin_amdgcn_exp2f(ltot0), __builtin_amdgcn_exp2f(ltot1)};
  }
#undef ROWOF
#undef LOADS
#undef PRE
#undef POST
}
}
constexpr int NWAVES = 8;
#ifndef MK_N_LAUNCHES
#define MK_N_LAUNCHES 1
#endif
constexpr int NPH = 11;
constexpr int N_LAUNCHES = MK_N_LAUNCHES;
static_assert(N_LAUNCHES == 1 || N_LAUNCHES == NPH, "MK_N_LAUNCHES is 1 or NPH");

constexpr int NB = 4, SEQ = 4096, DM = 2048, M = NB * SEQ, FFD = 8192, NIN = 6144  , NIN_SRC = 5952, NMOD = 6 * DM;
constexpr size_t MiB = 1u << 20;
constexpr size_t WS_CTL = 0, CTL_ZERO_BYTES = 64 * 1024;
constexpr size_t WS_WIN = 1 * MiB, WS_QR = 1 * MiB  , WS_WUQ = 25 * MiB, WS_WUKV = 27 * MiB, WS_WOUT = 28 * MiB, WS_WUP = 36 * MiB, WS_WDN = 68 * MiB;
constexpr size_t WS_LBV = 100 * MiB + 512 * 1024, WS_MOD = 100 * MiB, WS_CS = 101 * MiB, WS_QSS = 105 * MiB, WS_KVSS = 105 * MiB + 512 * 1024, WS_RSS = 106 * MiB, WS_KR = 108 * MiB;
constexpr size_t WS_XN = 112 * MiB, WS_OF = 112 * MiB, WS_OB = 144 * MiB, WS_Y = 112 * MiB;
constexpr size_t WS_HQ = 176 * MiB, WS_FF = 208 * MiB, WS_FB = 240 * MiB, WS_HI = 272 * MiB, WS_HG = 304 * MiB, WS_QN = 336 * MiB, WS_KN = 368 * MiB, WS_V = 400 * MiB;
constexpr size_t WS_QL = 432 * MiB, WS_KVL = 448 * MiB, WS_MIXIN = 448 * MiB, WS_MIX = 176 * MiB, WS_H = 176 * MiB, WS_END = 512 * MiB;
constexpr int CW_BAR = 4096;
constexpr int RING_OFF = 0, RING_BYTES = 131072, LDSCTL_OFF = RING_BYTES, MISC_OFF = LDSCTL_OFF + 320, LDS_BYTES = 147456;
static_assert(att::LDS_BYTES <= RING_BYTES && hg::LDS_BYTES <= RING_BYTES, "phase scratch inside the ring");

#define GAS __attribute__((address_space(1)))
#define LAS __attribute__((address_space(3)))
typedef unsigned short bf16;
typedef unsigned v4u __attribute__((ext_vector_type(4)));
typedef float f32x4 __attribute__((ext_vector_type(4)));
typedef short bf16x8 __attribute__((ext_vector_type(8)));
typedef GAS unsigned gu32;
typedef GAS unsigned long long gu64;
#define RLX_AGENT __ATOMIC_RELAXED, __HIP_MEMORY_SCOPE_AGENT
#define LDS_WAIT() asm volatile("s_waitcnt lgkmcnt(0)" ::: "memory")
#define VM_WAIT() asm volatile("s_waitcnt vmcnt(0)" ::: "memory")
__device__ __forceinline__ unsigned long long rt() { return __builtin_amdgcn_s_memrealtime(); }
__device__ __forceinline__ unsigned f2bf(float f) { unsigned u = __builtin_bit_cast(unsigned, f); return (u + 0x7fffu + ((u >> 16) & 1u)) >> 16; }
__device__ __forceinline__ unsigned pk2(float lo, float hi) { return f2bf(lo) | (f2bf(hi) << 16); }
#define XB_TMO      128
#define XB_XCNT(j)  (256  + 64 * (j))
#define XB_XSUB(j)  (1280 + 64 * (j))
#define XB_XGEN(j)  (2304 + 64 * (j))
#define XB_TOP      3328
#define XB_TOPGEN   3392
#define XCD_BAR_WORDS 3456
#define XB_SPIN_CAP (1u << 18)

__device__ __forceinline__ unsigned xb_ld(unsigned* p)              { return __hip_atomic_load(p, __ATOMIC_RELAXED, __HIP_MEMORY_SCOPE_AGENT); }
__device__ __forceinline__ unsigned xb_add(unsigned* p, unsigned v) { return __hip_atomic_fetch_add(p, v, __ATOMIC_RELAXED, __HIP_MEMORY_SCOPE_AGENT); }
__device__ __forceinline__ unsigned xb_xcc_id() { return (unsigned)__builtin_amdgcn_s_getreg((3 << 11) | 20) & 0xFu; }
#define XB_SPIN(cond, bar) do { unsigned _sp = 0; while (cond) { __builtin_amdgcn_s_sleep(1); \
    if ((++_sp & 255u) == 0u) { if (xb_ld(&(bar)[XB_TMO])) break; if (_sp > XB_SPIN_CAP) { atomicAdd(&(bar)[XB_TMO], 1u); break; } } } } while (0)

struct XcdBarrier {
    unsigned* bar; unsigned x;
    volatile LAS unsigned* st;
};

__device__ __forceinline__ XcdBarrier xcd_barrier_post(unsigned* bar, volatile LAS unsigned* st) {
    XcdBarrier b; b.bar = bar; b.x = xb_xcc_id(); b.st = st;
    if (threadIdx.x == 0) (void)xb_add(&bar[XB_XCNT(b.x)], 1u);
    return b;
}
__device__ __forceinline__ void xcd_barrier_complete(unsigned* bar, unsigned x, unsigned& nloc, unsigned& nx) {
    const unsigned G = gridDim.x * gridDim.y * gridDim.z;
    unsigned sum, cnt, mine, sp = 0u;
    for (;;) {
        sum = 0u; cnt = 0u; mine = 0u;
#pragma unroll
        for (unsigned j = 0; j < 16; ++j) { const unsigned c = xb_ld(&bar[XB_XCNT(j)]); sum += c; cnt += (c > 0u) ? 1u : 0u; mine = (j == x) ? c : mine; }
        if (sum == G) break;
        __builtin_amdgcn_s_sleep(1);
        if ((++sp & 255u) == 0u) { if (xb_ld(&bar[XB_TMO])) break; if (sp > XB_SPIN_CAP) { atomicAdd(&bar[XB_TMO], 1u); break; } }
    }
    nloc = mine > 0u ? mine : 1u; nx = cnt > 0u ? cnt : 1u;
}

__device__ __forceinline__ void xcd_barrier(const XcdBarrier& b) {
    asm volatile("s_waitcnt vmcnt(0)" ::: "memory");
    __syncthreads();
    if (threadIdx.x == 0) {
        unsigned* bar = b.bar;
        __builtin_amdgcn_s_waitcnt(0);
        unsigned nloc = b.st[0], nx = b.st[1];
        if (nloc == 0u) { xcd_barrier_complete(bar, b.x, nloc, nx); b.st[0] = nloc; b.st[1] = nx; }
        const unsigned old = xb_add(&bar[XB_XSUB(b.x)], 1u);
        const unsigned gen = old / nloc;
        if (old + 1u == (gen + 1u) * nloc) {
            __builtin_amdgcn_fence(__ATOMIC_RELEASE, "agent");
            asm volatile("s_waitcnt vmcnt(0)" ::: "memory");
            const unsigned og = xb_add(&bar[XB_TOP], 1u);
            const unsigned tg = og / nx;
            if (og + 1u == (tg + 1u) * nx) xb_add(&bar[XB_TOPGEN], 1u);
            else XB_SPIN(xb_ld(&bar[XB_TOPGEN]) == tg, bar);
            __builtin_amdgcn_fence(__ATOMIC_ACQUIRE, "agent");
            xb_add(&bar[XB_XGEN(b.x)], 1u);
            asm volatile("s_waitcnt vmcnt(0)" ::: "memory");
        } else {
            XB_SPIN(xb_ld(&bar[XB_XGEN(b.x)]) == gen, bar);
            __builtin_amdgcn_fence(__ATOMIC_ACQUIRE, "agent");
            asm volatile("s_waitcnt vmcnt(0)" ::: "memory");
        }
    }
    __syncthreads();
}

__device__ __forceinline__ float wave_sum(float v) {
#pragma unroll
    for (int o = 1; o < 64; o <<= 1) v += __shfl_xor(v, o);
    return v;
}
__device__ __forceinline__ float bf2f(unsigned short h) { return __builtin_bit_cast(float, (unsigned)h << 16); }
__device__ __forceinline__ float bflo(unsigned w) { return __builtin_bit_cast(float, w << 16); }
__device__ __forceinline__ float bfhi(unsigned w) { return __builtin_bit_cast(float, w & 0xffff0000u); }
__device__ __forceinline__ float sigmoidf_(float x) { return 1.0f / (1.0f + __expf(-x)); }

struct Args { const float* in[20]; float* out; unsigned char* ws; int ph_lo, ph_hi; };
struct Ctx { int tid, lane, wave, vcu, G; LAS unsigned char* lds; };

template <int MODE> __device__ __forceinline__ int src_col(int n) {
    if (MODE == 1) { if (n < 768) return n; if (n < 5888) return n + 64; if (n < 5952) { const int j = n - 5888; return 768 + (j & 1) * 32 + (j >> 1); } return -1; }
    if (MODE == 2) { if (n < 1024) return (n >> 7) * 192 + (n & 127); const int r = n - 1024, h = r >> 6, j = r & 63; return h * 192 + 128 + (j & 1) * 32 + (j >> 1); }
    return n;
}
template <int MODE> __device__ __forceinline__ void transpose_item(const float* W, int K, int Nsrc, int Ndst, const float* gain, bf16* WT, LAS float* scr, int item, int lane) {
    const int nblk = Ndst / 32, kb = item / nblk, nb = item % nblk, k0 = 64 * kb, n0 = 32 * nb;
    const int c = src_col<MODE>(n0 + (lane & 31));
#pragma unroll 8
    for (int i = 0; i < 32; ++i) { const int kk = 2 * i + (lane >> 5); float v = 0.f; if (c >= 0) v = W[(size_t)(k0 + kk) * Nsrc + c]; if (gain) v *= gain[k0 + kk]; scr[kk * 33 + (lane & 31)] = v; }
    LDS_WAIT(); asm volatile("" ::: "memory");
    const int cc = lane & 7;
#pragma unroll
    for (int j = 0; j < 4; ++j) { const int n = (lane >> 3) + 8 * j; const LAS float* s = scr + (8 * cc) * 33 + n;
        v4u o; o.x = pk2(s[0 * 33], s[1 * 33]); o.y = pk2(s[2 * 33], s[3 * 33]); o.z = pk2(s[4 * 33], s[5 * 33]); o.w = pk2(s[6 * 33], s[7 * 33]);
        *(GAS v4u*)(WT + (size_t)(n0 + n) * K + k0 + 8 * cc) = o; }
    LDS_WAIT(); asm volatile("" ::: "memory");
}

__global__ void __launch_bounds__(NWAVES * 64, 2) mk_fwd(Args args) {
    extern __shared__ __attribute__((aligned(16))) unsigned char lds[];
    Ctx C; C.lds = (LAS unsigned char*)lds; C.tid = threadIdx.x; C.lane = C.tid & 63; C.wave = __builtin_amdgcn_readfirstlane(C.tid >> 6);
    C.G = gridDim.x; { const int bx = blockIdx.x; C.vcu = (C.G % 8 == 0) ? (bx % 8) * (C.G / 8) + bx / 8 : bx; }
    volatile LAS unsigned* MISC = (volatile LAS unsigned*)(C.lds + MISC_OFF);
    unsigned char* ws = args.ws;
    gu32* ctl = (gu32*)(ws + WS_CTL);
    for (int u = C.tid; u < (LDS_BYTES - LDSCTL_OFF) / 4; u += NWAVES * 64) ((LAS unsigned*)(C.lds + LDSCTL_OFF))[u] = 0u;
    __syncthreads();
    XcdBarrier bar; bar.bar = (unsigned*)(ctl + CW_BAR); bar.x = 0; bar.st = nullptr;
    if (N_LAUNCHES == 1) bar = xcd_barrier_post((unsigned*)(ctl + CW_BAR), MISC + 8);
#define GRID_BAR() do { if (N_LAUNCHES == 1) xcd_barrier(bar); } while (0)
    const int lo = args.ph_lo, hi = args.ph_hi;
#ifndef PH_MASK
#define PH_MASK 0xfff
#endif
#define IN(k) (((PH_MASK >> (k)) & 1) && lo <= (k) && (k) < hi)
#define BOTH(k) (IN(k) && IN((k) + 1))
#ifndef REP_MASK
#define REP_MASK 0
#endif
#define REPS(k) (1 + ((REP_MASK >> (k)) & 1))
    const int gw = C.vcu * NWAVES + C.wave, NGW = C.G * NWAVES;
    const float* x = args.in[0]; const float* cin = args.in[1]; const int* positions = (const int*)args.in[2];
    const float* w_mod = args.in[3]; const float* b_mod = args.in[4]; const float* pre_mix_g = args.in[5]; const float* post_mix_g = args.in[6];
    const float* pre_mlp_g = args.in[7]; const float* post_mlp_g = args.in[8]; const float* w_in = args.in[9]; const float* q_norm_g = args.in[10]; const float* kv_norm_g = args.in[11];
    const float* w_uq = args.in[12]; const float* w_ukv = args.in[13]; const float* hgrn_norm_g = args.in[14]; const float* lbl_f = args.in[15]; const float* lbl_b = args.in[16];
    const float* w_out = args.in[17]; const float* w_up = args.in[18]; const float* w_down = args.in[19];
    float* out = args.out;
    bf16* Win_t = (bf16*)(ws + WS_WIN); bf16* Wuq_t = (bf16*)(ws + WS_WUQ); bf16* Wukv_t = (bf16*)(ws + WS_WUKV); bf16* Wout_t = (bf16*)(ws + WS_WOUT); bf16* Wup_t = (bf16*)(ws + WS_WUP); bf16* Wdn_t = (bf16*)(ws + WS_WDN);
    float* mod = (float*)(ws + WS_MOD); float* cs = (float*)(ws + WS_CS); float* qss = (float*)(ws + WS_QSS); float* kvss = (float*)(ws + WS_KVSS); float* rss = (float*)(ws + WS_RSS);
    bf16* KR = (bf16*)(ws + WS_KR); bf16* XN = (bf16*)(ws + WS_XN); bf16* OF = (bf16*)(ws + WS_OF); bf16* OB = (bf16*)(ws + WS_OB); bf16* Y = (bf16*)(ws + WS_Y);
    bf16* HQ = (bf16*)(ws + WS_HQ); bf16* FF = (bf16*)(ws + WS_FF); bf16* FB = (bf16*)(ws + WS_FB); bf16* HI = (bf16*)(ws + WS_HI); bf16* HG = (bf16*)(ws + WS_HG);
    bf16* QN = (bf16*)(ws + WS_QN); bf16* QR = (bf16*)(ws + WS_QR); bf16* KN = (bf16*)(ws + WS_KN); bf16* V = (bf16*)(ws + WS_V); bf16* QL = (bf16*)(ws + WS_QL); bf16* KVL = (bf16*)(ws + WS_KVL);
    float* lbv = (float*)(ws + WS_LBV); float* SLOC = out; float* DSEG = out + 3 * 1024 * 1024;
    bf16* MIXIN = (bf16*)(ws + WS_MIXIN); bf16* MIX = (bf16*)(ws + WS_MIX); bf16* H = (bf16*)(ws + WS_H);

    if (IN(0)) {
      for (int rep_ = 0; rep_ < REPS(0); ++rep_) {
        for (int u = C.vcu; u < NMOD / 64; u += C.G) {
            LAS float* condT = (LAS float*)(C.lds);
            LAS float* part = (LAS float*)(C.lds + 32768);
            for (int k = C.tid; k < DM; k += NWAVES * 64) {
#pragma unroll
                for (int b = 0; b < NB; ++b) { const float c = cin[b * DM + k]; condT[k * 4 + b] = c * sigmoidf_(c); } }
            __syncthreads();
            const int col = 64 * u + C.lane; f32x4 acc = {0.f, 0.f, 0.f, 0.f};
            const float* wp = w_mod + (size_t)(C.wave * 256) * NMOD + col;
#pragma unroll 8
            for (int k = 0; k < 256; ++k) { const float w = wp[(size_t)k * NMOD]; const f32x4 cv = *(const LAS f32x4*)(condT + (C.wave * 256 + k) * 4); acc += cv * w; }
#pragma unroll
            for (int b = 0; b < NB; ++b) part[(C.wave * 4 + b) * 64 + C.lane] = acc[b];
            __syncthreads();
            if (C.tid < 256) { const int b = C.tid >> 6, l = C.tid & 63; float s = b_mod[64 * u + l];
#pragma unroll
                for (int w = 0; w < 8; ++w) s += part[(w * 4 + b) * 64 + l];
                mod[b * NMOD + 64 * u + l] = s; }
            __syncthreads();
        }
        for (int idx = gw * 64 + C.lane; idx < 2048; idx += NGW * 64) { const float* lp = idx < 1024 ? lbl_f : lbl_b; const int j = idx & 1023; lbv[idx] = 1.0f / (1.0f + __expf(lp[1024 + j] - lp[j])); }
        for (int idx = gw * 64 + C.lane; idx < M * 32; idx += NGW * 64) { const int row = idx >> 5, i = idx & 31;
            const float invf = powf(10000.0f, -(float)i * (1.0f / 32.0f)); const float ang = (float)positions[row] * invf;
            pg8::f32x2 v; v.x = cosf(ang); v.y = sinf(ang); *(pg8::f32x2*)(cs + (size_t)idx * 2) = v; }
        LAS float* scr = (LAS float*)(C.lds + RING_OFF + C.wave * 16384);
        constexpr int I_IN = (DM / 64) * (NIN / 32), I_UQ = (512 / 64) * (1536 / 32), I_UKV = (256 / 64) * (2048 / 32), I_OUT = (DM / 64) * (DM / 32), I_UP = (DM / 64) * (FFD / 32), I_DN = (FFD / 64) * (DM / 32);
        constexpr int NITEMS = I_IN + I_UQ + I_UKV + I_OUT + I_UP + I_DN;
        for (int it = gw; it < NITEMS; it += NGW) {
            int r = it;
            if (r < I_IN) { transpose_item<1>(w_in, DM, NIN_SRC, NIN, nullptr, Win_t, scr, r, C.lane); continue; } r -= I_IN;
            if (r < I_UQ) { transpose_item<2>(w_uq, 512, 1536, 1536, q_norm_g, Wuq_t, scr, r, C.lane); continue; } r -= I_UQ;
            if (r < I_UKV) { transpose_item<0>(w_ukv, 256, 2048, 2048, kv_norm_g, Wukv_t, scr, r, C.lane); continue; } r -= I_UKV;
            if (r < I_OUT) { transpose_item<0>(w_out, DM, DM, DM, nullptr, Wout_t, scr, r, C.lane); continue; } r -= I_OUT;
            if (r < I_UP) { transpose_item<0>(w_up, DM, FFD, FFD, nullptr, Wup_t, scr, r, C.lane); continue; } r -= I_UP;
            transpose_item<0>(w_down, FFD, DM, DM, nullptr, Wdn_t, scr, r, C.lane);
        }
      }
        if (BOTH(0)) GRID_BAR();
    }
    if (IN(1)) {
      for (int rep_ = 0; rep_ < REPS(1); ++rep_) {
        for (int r = gw; r < M; r += NGW) { const int b = r / SEQ; const float* mb = mod + b * NMOD;
            const GAS f32x4* xr = (const GAS f32x4*)(x + (size_t)r * DM) + C.lane; f32x4 v[8]; float s = 0.f;
#pragma unroll
            for (int j = 0; j < 8; ++j) { v[j] = xr[64 * j]; s += (v[j].x * v[j].x + v[j].y * v[j].y) + (v[j].z * v[j].z + v[j].w * v[j].w); }
            const float rstd = 1.0f / sqrtf(wave_sum(s) * (1.0f / DM) + 1e-6f);
            GAS unsigned long long* o8 = (GAS unsigned long long*)(XN + (size_t)r * DM) + C.lane;
#pragma unroll
            for (int j = 0; j < 8; ++j) { const int c0 = 4 * C.lane + 256 * j; const f32x4 g = *(const f32x4*)(pre_mix_g + c0), sh = *(const f32x4*)(mb + c0), sc = *(const f32x4*)(mb + DM + c0);
                const f32x4 h = v[j] * rstd * g * (sc + 1.0f) + sh;
                o8[64 * j] = (unsigned long long)pk2(h.x, h.y) | ((unsigned long long)pk2(h.z, h.w) << 32); } }
      }
        if (BOTH(1)) GRID_BAR();
    }
    if (IN(2)) {
      for (int rep_ = 0; rep_ < REPS(2); ++rep_) {
        pg8::Gemm g{XN, Win_t, M, NIN, DM}; pg8::StaticOrder S; S.init(M, NIN, C.G, (int)blockIdx.x);
        pg8::EpiProj E{QL, KVL, HQ, FF, FB, HI, HG, KR, qss, kvss, cs, lbv};
        pg8::gemm_phase<pg8::EpiProj, pg8::StaticOrder, PG8_ALIGN, PG8_SP2>(C.lds + RING_OFF, g, S, E);
      }
        if (BOTH(2)) GRID_BAR();
    }
    if (IN(3)) {
      for (int rep_ = 0; rep_ < REPS(3); ++rep_) {
        { pg8::Gemm g{QL, Wuq_t, M, 1536, 512}; pg8::StaticOrder S; S.init(M, 1536, C.G, (int)blockIdx.x);
          pg8::EpiQ E{QN, QR, qss, cs};
          pg8::gemm_phase<pg8::EpiQ, pg8::StaticOrder, PG8_ALIGN, PG8_SP2>(C.lds + RING_OFF, g, S, E); }
        { pg8::Gemm g{KVL, Wukv_t, M, 2048, 256}; pg8::StaticOrder S; S.init(M, 2048, C.G, (int)blockIdx.x);
          pg8::EpiKV E{KN, V, kvss};
          pg8::gemm_phase<pg8::EpiKV, pg8::StaticOrder, PG8_ALIGN, PG8_SP2>(C.lds + RING_OFF, g, S, E); }
        if ((PH_MASK >> 11) & 1) {
            for (int slot = C.vcu; slot < 256; slot += C.G) { const int ch = slot >> 2, seg = slot & 3, dir = ch & 1;
                if (seg < 3) hg::hgrn_seg<true>(ch, seg, (const unsigned short*)HQ, (const unsigned short*)(dir ? FB : FF), (const unsigned short*)HI, nullptr, SLOC, DSEG, (char*)lds + RING_OFF); }
        }
      }
        if (BOTH(3)) GRID_BAR();
    }
    if (IN(4) || (((PH_MASK >> 11) & 1) && lo <= 4 && 4 < hi)) {
        for (int rep_ = 0; rep_ < REPS(4); ++rep_)
        if ((PH_MASK >> 4) & 1) { const att::Tens T{(const short*)QN, (const short*)QR, (const short*)KN, (const short*)KR, (const short*)V, (unsigned short*)MIXIN};
          const int per = (512 + C.G - 1) / C.G;
          for (int i = 0; i < per; ++i) { const int id = C.vcu * per + i; if (id >= 512) break; const int bh = id >> 4, qb = id & 15; att::attn_unit(bh >> 3, bh & 7, qb, T, (char*)lds + RING_OFF); } }
        for (int rep_ = 0; rep_ < REPS(11); ++rep_)
        if ((PH_MASK >> 11) & 1) {
            for (int slot = C.vcu; slot < 256; slot += C.G) { const int ch = slot >> 2, seg = slot & 3, dir = ch & 1;
                hg::hgrn_seg<false>(ch, seg, (const unsigned short*)HQ, (const unsigned short*)(dir ? FB : FF), (const unsigned short*)HI, (unsigned short*)(dir ? OB : OF), SLOC, DSEG, (char*)lds + RING_OFF); }
        }
        if (BOTH(4)) GRID_BAR();
    }
    if (IN(5)) {
      for (int rep_ = 0; rep_ < REPS(5); ++rep_) {
        for (int r = gw; r < M; r += NGW) { const size_t o16 = (size_t)r * 1024 + 16 * C.lane;
            const v4u a0 = *(const GAS v4u*)(OF + o16), a1 = *(const GAS v4u*)(OF + o16 + 8), b0 = *(const GAS v4u*)(OB + o16), b1 = *(const GAS v4u*)(OB + o16 + 8);
            const v4u g0 = *(const GAS v4u*)(HG + o16), g1 = *(const GAS v4u*)(HG + o16 + 8);
            float sv[16]; float ss = 0.f;
#pragma unroll
            for (int i = 0; i < 4; ++i) { sv[2 * i] = bflo(a0[i]) + bflo(b0[i]); sv[2 * i + 1] = bfhi(a0[i]) + bfhi(b0[i]); sv[8 + 2 * i] = bflo(a1[i]) + bflo(b1[i]); sv[8 + 2 * i + 1] = bfhi(a1[i]) + bfhi(b1[i]); }
#pragma unroll
            for (int i = 0; i < 16; ++i) ss += sv[i] * sv[i];
            ss += __shfl_xor(ss, 1); ss += __shfl_xor(ss, 2); ss += __shfl_xor(ss, 4);
            const float rstd = 1.0f / sqrtf(ss * (1.0f / 128.0f) + 1e-6f);
            const float* gp = hgrn_norm_g + ((16 * C.lane) & 127); float ov[16];
#pragma unroll
            for (int i = 0; i < 4; ++i) { const float h0 = bflo(g0[i]), h1 = bfhi(g0[i]), h2 = bflo(g1[i]), h3 = bfhi(g1[i]);
                ov[2 * i] = sv[2 * i] * rstd * gp[2 * i] * (h0 * sigmoidf_(h0)); ov[2 * i + 1] = sv[2 * i + 1] * rstd * gp[2 * i + 1] * (h1 * sigmoidf_(h1));
                ov[8 + 2 * i] = sv[8 + 2 * i] * rstd * gp[8 + 2 * i] * (h2 * sigmoidf_(h2)); ov[8 + 2 * i + 1] = sv[8 + 2 * i + 1] * rstd * gp[8 + 2 * i + 1] * (h3 * sigmoidf_(h3)); }
            v4u w0, w1;
#pragma unroll
            for (int i = 0; i < 4; ++i) { w0[i] = pk2(ov[2 * i], ov[2 * i + 1]); w1[i] = pk2(ov[8 + 2 * i], ov[8 + 2 * i + 1]); }
            bf16* op = MIXIN + (size_t)r * 2048 + 1024 + 16 * C.lane; *(GAS v4u*)op = w0; *(GAS v4u*)(op + 8) = w1; }
      }
        if (BOTH(5)) GRID_BAR();
    }
    if (IN(6)) {
      for (int rep_ = 0; rep_ < REPS(6); ++rep_) {
        pg8::Gemm g{MIXIN, Wout_t, M, DM, DM}; pg8::StaticOrder S; S.init(M, DM, C.G, (int)blockIdx.x);
        pg8::EpiOut<0, true> E{MIX, DM, rss};
        pg8::gemm_phase<pg8::EpiOut<0, true>, pg8::StaticOrder, PG8_ALIGN, PG8_SP2>(C.lds + RING_OFF, g, S, E);
      }
        if (BOTH(6)) GRID_BAR();
    }
    if (IN(7)) {
      for (int rep_ = 0; rep_ < REPS(7); ++rep_) {
        for (int r = gw; r < M; r += NGW) { const int b = r / SEQ; const float* mb = mod + b * NMOD;
            const float sm = wave_sum(C.lane < 32 ? rss[(size_t)r * 32 + C.lane] : 0.f); const float rstd_m = 1.0f / sqrtf(sm * (1.0f / DM) + 1e-6f);
            const GAS f32x4* xr = (const GAS f32x4*)(x + (size_t)r * DM) + C.lane; const GAS unsigned long long* mr = (const GAS unsigned long long*)(MIX + (size_t)r * DM) + C.lane;
            GAS f32x4* orow = (GAS f32x4*)(out + (size_t)r * DM) + C.lane;
            f32x4 v[8]; float s = 0.f;
#pragma unroll
            for (int j = 0; j < 8; ++j) { const int c0 = 4 * C.lane + 256 * j; const unsigned long long mw = mr[64 * j]; const unsigned lo_ = (unsigned)mw, hi_ = (unsigned)(mw >> 32);
                const f32x4 mx = {bflo(lo_), bfhi(lo_), bflo(hi_), bfhi(hi_)}; const f32x4 g = *(const f32x4*)(post_mix_g + c0), ga = *(const f32x4*)(mb + 2 * DM + c0);
                v[j] = xr[64 * j] + ga * (mx * rstd_m * g); orow[64 * j] = v[j];
                s += (v[j].x * v[j].x + v[j].y * v[j].y) + (v[j].z * v[j].z + v[j].w * v[j].w); }
            const float rstd = 1.0f / sqrtf(wave_sum(s) * (1.0f / DM) + 1e-6f);
            GAS unsigned long long* o8 = (GAS unsigned long long*)(XN + (size_t)r * DM) + C.lane;
#pragma unroll
            for (int j = 0; j < 8; ++j) { const int c0 = 4 * C.lane + 256 * j; const f32x4 g = *(const f32x4*)(pre_mlp_g + c0), sh = *(const f32x4*)(mb + 3 * DM + c0), sc = *(const f32x4*)(mb + 4 * DM + c0);
                const f32x4 h = v[j] * rstd * g * (sc + 1.0f) + sh;
                o8[64 * j] = (unsigned long long)pk2(h.x, h.y) | ((unsigned long long)pk2(h.z, h.w) << 32); } }
      }
        if (BOTH(7)) GRID_BAR();
    }
    if (IN(8)) {
      for (int rep_ = 0; rep_ < REPS(8); ++rep_) {
        pg8::Gemm g{XN, Wup_t, M, FFD, DM}; pg8::StaticOrder S; S.init(M, FFD, C.G, (int)blockIdx.x);
        pg8::EpiOut<1, false> E{H, FFD, nullptr};
        pg8::gemm_phase<pg8::EpiOut<1, false>, pg8::StaticOrder, PG8_ALIGN, PG8_SP2>(C.lds + RING_OFF, g, S, E);
      }
        if (BOTH(8)) GRID_BAR();
    }
    if (IN(9)) {
      for (int rep_ = 0; rep_ < REPS(9); ++rep_) {
        pg8::Gemm g{H, Wdn_t, M, DM, FFD}; pg8::StaticOrder S; S.init(M, DM, C.G, (int)blockIdx.x);
        pg8::EpiOut<0, true> E{Y, DM, rss};
        pg8::gemm_phase<pg8::EpiOut<0, true>, pg8::StaticOrder, PG8_ALIGN, PG8_SP2>(C.lds + RING_OFF, g, S, E);
      }
        if (BOTH(9)) GRID_BAR();
    }
    if (IN(10)) {
        for (int r = gw; r < M; r += NGW) { const int b = r / SEQ; const float* mb = mod + b * NMOD;
            const float sm = wave_sum(C.lane < 32 ? rss[(size_t)r * 32 + C.lane] : 0.f); const float rstd_y = 1.0f / sqrtf(sm * (1.0f / DM) + 1e-6f);
            const GAS unsigned long long* yr = (const GAS unsigned long long*)(Y + (size_t)r * DM) + C.lane; GAS f32x4* orow = (GAS f32x4*)(out + (size_t)r * DM) + C.lane;
#pragma unroll
            for (int j = 0; j < 8; ++j) { const int c0 = 4 * C.lane + 256 * j; const unsigned long long yw = yr[64 * j]; const unsigned lo_ = (unsigned)yw, hi_ = (unsigned)(yw >> 32);
                const f32x4 yx = {bflo(lo_), bfhi(lo_), bflo(hi_), bfhi(hi_)}; const f32x4 g = *(const f32x4*)(post_mlp_g + c0), gm = *(const f32x4*)(mb + 5 * DM + c0);
                orow[64 * j] = orow[64 * j] + gm * (yx * rstd_y * g); } }
    }
#undef IN
#undef BOTH
#undef GRID_BAR
}

extern "C" void kernel_launch(void* const* d_in, const int* in_sizes, int n_in, void* d_out, int out_size, void* d_ws, size_t ws_size, hipStream_t stream) {
    static int grid = 0;
    if (grid == 0) {
        if (n_in != 20 || in_sizes[0] != M * DM || out_size != M * DM || ws_size < WS_END) { fprintf(stderr, "kernel_launch: unexpected shapes: n_in %d in0 %d out %d ws %zu (need %zu)\n", n_in, n_in > 0 ? in_sizes[0] : -1, out_size, ws_size, (size_t)WS_END); grid = -1; return; }
        int dev = 0, cus = 0;
        if (hipGetDevice(&dev) != hipSuccess || hipDeviceGetAttribute(&cus, hipDeviceAttributeMultiprocessorCount, dev) != hipSuccess) { fprintf(stderr, "kernel_launch: device query failed\n"); grid = -1; return; }
        if (hipFuncSetAttribute((const void*)mk_fwd, hipFuncAttributeMaxDynamicSharedMemorySize, LDS_BYTES) != hipSuccess) { fprintf(stderr, "kernel_launch: hipFuncSetAttribute failed\n"); grid = -1; return; }
        int per_cu = 0;
        if (hipOccupancyMaxActiveBlocksPerMultiprocessor(&per_cu, (const void*)mk_fwd, NWAVES * 64, LDS_BYTES) != hipSuccess || per_cu < 1) fprintf(stderr, "kernel_launch: note: occupancy query reports %d workgroups per CU\n", per_cu);
        (void)hipGetLastError();
        grid = cus;
    }
    if (grid < 0) return;
    if (hipMemsetAsync((char*)d_ws + WS_CTL, 0, CTL_ZERO_BYTES, stream) != hipSuccess) { fprintf(stderr, "kernel_launch: memset failed\n"); return; }
    Args a{};
    for (int i = 0; i < 20; ++i) a.in[i] = (const float*)d_in[i];
    a.out = (float*)d_out; a.ws = (unsigned char*)d_ws;
    for (int li = 0; li < N_LAUNCHES; ++li) {
        a.ph_lo = (N_LAUNCHES == 1) ? 0 : li; a.ph_hi = (N_LAUNCHES == 1) ? NPH : li + 1;
        hipLaunchKernelGGL(mk_fwd, dim3(grid), dim3(NWAVES * 64), LDS_BYTES, stream, a);
        const hipError_t le = hipPeekAtLastError();
        if (le != hipSuccess) { fprintf(stderr, "kernel_launch: launch %d failed: %s\n", li, hipGetErrorName(le)); break; }
    }
}
```
